# Optimizing an MI355X kernel written in HIP

```python
import math
import jax, jax.numpy as jnp
from jax import lax
import numpy as np

D_MODEL = 1024
BATCH = 8
SEQ = 4096
DEPTH = 2

N_MIXERS = 2
N_A_LAYERS = (DEPTH + 1) // 2
N_B_LAYERS = DEPTH // 2
Q_BLOCK = 128
NORM_EPS = 1e-6
MASK_VALUE = -1e30
DA_HEADS = D_MODEL // 128
DA_DK = D_MODEL // (2 * DA_HEADS)
DA_DV = 2 * DA_DK
DA_QK_WIDTH = DA_HEADS * 2 * DA_DK
DA_V_WIDTH = DA_HEADS * DA_DV
ROPE_THETA = 500000.0
ROPE_DIMS = DA_DK // 4
SB_HEADS = D_MODEL // 64
SB_HD = D_MODEL // SB_HEADS
SB_WIDTH = SB_HEADS * SB_HD
MOE_GROUPS = 4
MOE_EPG = 8
MOE_E = MOE_GROUPS * MOE_EPG
MOE_K = 2
MOE_FF = D_MODEL // 2
MOE_BLOCK = 128

kernel_name = "hybrid_diffattn_stickbreak_hmoe"


def rmsnorm(x, g):
    xf = x.astype(jnp.float32)
    y = xf * lax.rsqrt(jnp.mean(xf * xf, axis=-1, keepdims=True) + NORM_EPS) * g.astype(jnp.float32)
    return y.astype(x.dtype)


def partial_rope(x, positions):
    inv_freq = ROPE_THETA ** (-jnp.arange(0, ROPE_DIMS, 2, dtype=jnp.float32) / ROPE_DIMS)
    ang = positions.astype(jnp.float32)[:, :, None] * inv_freq[None, None, :]
    cos = jnp.cos(ang)[:, :, None, None, :]
    sin = jnp.sin(ang)[:, :, None, None, :]
    xr = x[..., :ROPE_DIMS].astype(jnp.float32)
    half = ROPE_DIMS // 2
    x1, x2 = xr[..., :half], xr[..., half:]
    rot = jnp.concatenate([x1 * cos - x2 * sin, x2 * cos + x1 * sin], axis=-1).astype(x.dtype)
    return jnp.concatenate([rot, x[..., ROPE_DIMS:]], axis=-1)


def diff_attention(h, positions, w_qkv, lq1, lk1, lq2, lk2, subln, w_o, layer_idx):
    B, S, _ = h.shape
    qkv = h @ w_qkv
    q = qkv[..., :DA_QK_WIDTH].reshape(B, S, DA_HEADS, 2, DA_DK)
    k = qkv[..., DA_QK_WIDTH:2 * DA_QK_WIDTH].reshape(B, S, DA_HEADS, 2, DA_DK)
    v = qkv[..., 2 * DA_QK_WIDTH:].reshape(B, S, DA_HEADS, DA_DV)
    q = partial_rope(q, positions)
    k = partial_rope(k, positions)
    lam_init = 0.8 - 0.6 * math.exp(-0.3 * layer_idx)
    lam = (jnp.exp(jnp.sum(lq1.astype(jnp.float32) * lk1.astype(jnp.float32)))
           - jnp.exp(jnp.sum(lq2.astype(jnp.float32) * lk2.astype(jnp.float32))) + lam_init)
    qh = q.transpose(0, 2, 3, 1, 4)
    kh = k.transpose(0, 2, 3, 1, 4)
    vh = v.transpose(0, 2, 1, 3)
    n_blk = S // Q_BLOCK
    q_blocks = qh.reshape(B, DA_HEADS, 2, n_blk, Q_BLOCK, DA_DK).transpose(3, 0, 1, 2, 4, 5)
    k_pos = jnp.arange(S, dtype=jnp.int32)
    scale = DA_DK ** -0.5

    def block(args):
        qb, bi = args
        s = jnp.einsum('bhmqd,bhmkd->bhmqk', qb, kh).astype(jnp.float32) * scale
        q_pos = bi * Q_BLOCK + jnp.arange(Q_BLOCK, dtype=jnp.int32)
        causal = k_pos[None, :] <= q_pos[:, None]
        p = jax.nn.softmax(jnp.where(causal, s, MASK_VALUE), axis=-1)
        w = p[:, :, 0] - lam * p[:, :, 1]
        return jnp.einsum('bhqk,bhkd->bhqd', w.astype(vh.dtype), vh)

    o = lax.map(block, (q_blocks, jnp.arange(n_blk, dtype=jnp.int32)))
    o = o.transpose(1, 0, 3, 2, 4).reshape(B, S, DA_HEADS, DA_DV)
    o = (rmsnorm(o, subln).astype(jnp.float32) * (1.0 - lam_init)).astype(h.dtype)
    return o.reshape(B, S, DA_V_WIDTH) @ w_o


def stick_breaking_attention(h, w_qkv, w_o):
    B, S, _ = h.shape
    qkv = h @ w_qkv
    q = qkv[..., :SB_WIDTH].reshape(B, S, SB_HEADS, SB_HD).transpose(0, 2, 1, 3)
    k = qkv[..., SB_WIDTH:2 * SB_WIDTH].reshape(B, S, SB_HEADS, SB_HD).transpose(0, 2, 1, 3)
    v = qkv[..., 2 * SB_WIDTH:].reshape(B, S, SB_HEADS, SB_HD).transpose(0, 2, 1, 3)
    n_blk = S // Q_BLOCK
    q_blocks = q.reshape(B, SB_HEADS, n_blk, Q_BLOCK, SB_HD).transpose(2, 0, 1, 3, 4)
    k_pos = jnp.arange(S, dtype=jnp.int32)
    scale = SB_HD ** -0.5

    def block(args):
        qb, bi = args
        z = jnp.einsum('bhqd,bhkd->bhqk', qb, k).astype(jnp.float32) * scale
        q_pos = bi * Q_BLOCK + jnp.arange(Q_BLOCK, dtype=jnp.int32)
        valid = k_pos[None, :] < q_pos[:, None]
        log_beta = jax.nn.log_sigmoid(z)
        log_1m = jnp.where(valid, log_beta - z, 0.0)
        tail = lax.cumsum(log_1m, axis=3, reverse=True) - log_1m
        a = jnp.where(valid, jnp.exp(jnp.where(valid, log_beta + tail, 0.0)), 0.0)
        return jnp.einsum('bhqk,bhkd->bhqd', a.astype(v.dtype), v)

    o = lax.map(block, (q_blocks, jnp.arange(n_blk, dtype=jnp.int32)))
    o = o.transpose(1, 0, 3, 2, 4).reshape(B, S, SB_WIDTH)
    return o @ w_o


def hierarchical_moe(h, w_group, b_group, w_expert, b_expert, w_gate, w_up, w_down):
    B, S, D = h.shape
    T = B * S
    xf = h.reshape(T, D)
    tok_ids = jnp.arange(T, dtype=jnp.int32)
    g_logits = (xf @ w_group).astype(jnp.float32) + b_group.astype(jnp.float32)[None, :]
    g_prob = jax.nn.softmax(g_logits, axis=-1)
    g_idx = jnp.argmax(g_logits, axis=-1).astype(jnp.int32)
    g_w = jnp.max(g_prob, axis=-1)
    e_logits = ((xf @ w_expert).astype(jnp.float32) + b_expert.astype(jnp.float32)[None, :]).reshape(T, MOE_GROUPS, MOE_EPG)
    e_logits = e_logits[tok_ids, g_idx]
    e_prob = jax.nn.softmax(e_logits, axis=-1)
    top_p, top_i = lax.top_k(e_prob, MOE_K)
    top_p = top_p / jnp.sum(top_p, axis=-1, keepdims=True)
    gate = g_w[:, None] * top_p
    expert = g_idx[:, None] * MOE_EPG + top_i.astype(jnp.int32)
    n_assign = T * MOE_K
    e_flat = expert.reshape(n_assign)
    tok_flat = jnp.broadcast_to(tok_ids[:, None], (T, MOE_K)).reshape(n_assign)
    gate_flat = gate.reshape(n_assign)
    order = jnp.argsort(e_flat)
    e_s, tok_s, gate_s = e_flat[order], tok_flat[order], gate_flat[order]
    counts = jnp.sum((e_s[:, None] == jnp.arange(MOE_E, dtype=jnp.int32)[None, :]).astype(jnp.int32), axis=0)
    starts = jnp.cumsum(counts) - counts
    padded = ((counts + MOE_BLOCK - 1) // MOE_BLOCK) * MOE_BLOCK
    pad_ends = jnp.cumsum(padded)
    pad_starts = pad_ends - padded
    dest = pad_starts[e_s] + jnp.arange(n_assign, dtype=jnp.int32) - starts[e_s]
    n_rows = n_assign + MOE_E * MOE_BLOCK
    n_blocks = n_rows // MOE_BLOCK
    row_tok = jnp.full((n_rows,), T, dtype=jnp.int32).at[dest].set(tok_s)
    row_gate = jnp.zeros((n_rows,), jnp.float32).at[dest].set(gate_s.astype(jnp.float32))
    block_start = jnp.arange(n_blocks, dtype=jnp.int32) * MOE_BLOCK
    block_expert = jnp.minimum(
        jnp.sum((pad_ends[None, :] <= block_start[:, None]).astype(jnp.int32), axis=1), MOE_E - 1)
    x_pad = jnp.concatenate([xf, jnp.zeros((1, D), xf.dtype)], axis=0)
    x_rows = x_pad[row_tok].reshape(n_blocks, MOE_BLOCK, D)

    def expert_block(args):
        xb, e, gb = args
        hid = jax.nn.silu(xb @ w_gate[e]) * (xb @ w_up[e])
        return ((hid @ w_down[e]).astype(jnp.float32) * gb[:, None]).astype(xb.dtype)

    y_rows = lax.map(expert_block, (x_rows, block_expert, row_gate.reshape(n_blocks, MOE_BLOCK)))
    out = jax.ops.segment_sum(y_rows.reshape(n_rows, D), row_tok, num_segments=T + 1)[:T]
    return out.reshape(B, S, D)


def setup_inputs(seed: int = 0) -> dict:
    key = jax.random.key(seed)
    ks = jax.random.split(key, 24)
    f32 = jnp.float32
    D = D_MODEL

    def nrm(k, shape, fan_in):
        return jax.random.normal(k, shape, f32) * (fan_in ** -0.5)

    x = jax.random.normal(ks[0], (BATCH, SEQ, D), f32)
    positions = (jnp.arange(SEQ, dtype=jnp.int32)[None, :]
                 + jax.random.randint(ks[1], (BATCH, 1), 0, 1024, dtype=jnp.int32))
    return {
        "x": x,
        "positions": positions,
        "norm_mix": 1.0 + 0.02 * jax.random.normal(ks[2], (DEPTH, D), f32),
        "norm_ffn": 1.0 + 0.02 * jax.random.normal(ks[3], (DEPTH, D), f32),
        "norm_final": 1.0 + 0.02 * jax.random.normal(ks[4], (D,), f32),
        "a_w_qkv": nrm(ks[5], (N_A_LAYERS, D, 2 * DA_QK_WIDTH + DA_V_WIDTH), D),
        "a_lambda_q1": 0.1 * jax.random.normal(ks[6], (N_A_LAYERS, DA_DK), f32),
        "a_lambda_k1": 0.1 * jax.random.normal(ks[7], (N_A_LAYERS, DA_DK), f32),
        "a_lambda_q2": 0.1 * jax.random.normal(ks[8], (N_A_LAYERS, DA_DK), f32),
        "a_lambda_k2": 0.1 * jax.random.normal(ks[9], (N_A_LAYERS, DA_DK), f32),
        "a_subln": 1.0 + 0.02 * jax.random.normal(ks[10], (N_A_LAYERS, DA_DV), f32),
        "a_w_o": nrm(ks[11], (N_A_LAYERS, DA_V_WIDTH, D), DA_V_WIDTH),
        "b_w_qkv": nrm(ks[12], (N_B_LAYERS, D, 3 * SB_WIDTH), D),
        "b_w_o": nrm(ks[13], (N_B_LAYERS, SB_WIDTH, D), SB_WIDTH),
        "moe_w_group": nrm(ks[14], (DEPTH, D, MOE_GROUPS), D),
        "moe_b_group": 0.01 * jax.random.normal(ks[15], (DEPTH, MOE_GROUPS), f32),
        "moe_w_expert": nrm(ks[16], (DEPTH, D, MOE_E), D),
        "moe_b_expert": 0.01 * jax.random.normal(ks[17], (DEPTH, MOE_E), f32),
        "moe_w_gate": nrm(ks[18], (DEPTH, MOE_E, D, MOE_FF), D),
        "moe_w_up": nrm(ks[19], (DEPTH, MOE_E, D, MOE_FF), D),
        "moe_w_down": nrm(ks[20], (DEPTH, MOE_E, MOE_FF, D), MOE_FF),
    }


def reference(x, positions, norm_mix, norm_ffn, norm_final, a_w_qkv, a_lambda_q1, a_lambda_k1,
              a_lambda_q2, a_lambda_k2, a_subln, a_w_o, b_w_qkv, b_w_o, moe_w_group, moe_b_group,
              moe_w_expert, moe_b_expert, moe_w_gate, moe_w_up, moe_w_down):
    h = x
    for i in range(DEPTH):
        hn = rmsnorm(h, norm_mix[i])
        j = i // N_MIXERS
        if i % N_MIXERS == 0:
            mix = diff_attention(hn, positions, a_w_qkv[j], a_lambda_q1[j], a_lambda_k1[j],
                                 a_lambda_q2[j], a_lambda_k2[j], a_subln[j], a_w_o[j], i)
        else:
            mix = stick_breaking_attention(hn, b_w_qkv[j], b_w_o[j])
        h = h + mix
        h = h + hierarchical_moe(rmsnorm(h, norm_ffn[i]), moe_w_group[i], moe_b_group[i],
                                 moe_w_expert[i], moe_b_expert[i], moe_w_gate[i],
                                 moe_w_up[i], moe_w_down[i])
    return rmsnorm(h, norm_final)
```

```cpp
#include <hip/hip_runtime.h>
#include <cstdint>
#include <cstdio>

#define LAS __attribute__((address_space(3)))
typedef unsigned short bf16_t;
typedef short bf16x8 __attribute__((ext_vector_type(8)));
typedef float f32x4 __attribute__((ext_vector_type(4)));
typedef float f32x16 __attribute__((ext_vector_type(16)));
typedef unsigned u32x4 __attribute__((ext_vector_type(4)));
typedef unsigned u32x2 __attribute__((ext_vector_type(2)));
typedef float f32x2_t __attribute__((ext_vector_type(2)));
typedef __bf16 bf16x2_t __attribute__((ext_vector_type(2)));

constexpr int DM = 1024, BATCH = 8, SEQ = 4096, T = BATCH * SEQ;
constexpr int NE = 32, EPG = 8, NG = 4, FF = 512;
constexpr float EPS = 1e-6f;
constexpr float LOG2E = 1.4426950408889634f, LN2 = 0.6931471805599453f;
constexpr int NWAVES = 8, NTHREADS = 512;
constexpr int ECAP = 32768;
constexpr int MAXROWS = 73728;

constexpr size_t MiB = 1u << 20;
constexpr size_t WS_CTL = 0, CTL_ZERO_BYTES = 1 * MiB;
constexpr size_t WS_ROPE = 1 * MiB;
constexpr size_t WS_RSTD_IN = 3 * MiB;
constexpr size_t WS_RSTD_FF = 3 * MiB + 256 * 1024;
constexpr size_t WS_TOKSLOT = 3 * MiB + 512 * 1024;
constexpr size_t WS_ROWTOK = 4 * MiB;
constexpr size_t WS_ROWGATE = 8 * MiB;
constexpr size_t WS_WR = 12 * MiB;
constexpr size_t WS_WQKV = 13 * MiB;
constexpr size_t WS_WO = 25 * MiB;
constexpr size_t WS_WGU = 29 * MiB;
constexpr size_t WS_WD = 93 * MiB;
constexpr size_t WS_HB = 125 * MiB;
constexpr size_t WS_Q = 189 * MiB, WS_K = 253 * MiB, WS_V = 317 * MiB;
constexpr size_t WS_Y = 189 * MiB;
constexpr size_t WS_AO = 381 * MiB;
constexpr size_t WS_HID = 445 * MiB;
constexpr size_t WS_END = 517 * MiB;
static_assert(WS_Y + (size_t)MAXROWS * 1024 * 2 <= WS_AO && WS_HID + (size_t)MAXROWS * 512 * 2 <= WS_END, "ws map");
constexpr int CW_CNT = 1024;

constexpr int LDS_BYTES = 147456;

__device__ __forceinline__ unsigned cvtpk(float lo, float hi) { f32x2_t v = {lo, hi}; bf16x2_t b = __builtin_convertvector(v, bf16x2_t); return __builtin_bit_cast(unsigned, b); }
__device__ __forceinline__ float bf2f(unsigned short b) { return __uint_as_float((unsigned)b << 16); }
__device__ __forceinline__ float bflo(unsigned w) { return __uint_as_float(w << 16); }
__device__ __forceinline__ float bfhi(unsigned w) { return __uint_as_float(w & 0xffff0000u); }
__device__ __forceinline__ int crow(int r, int hi) { return (r & 3) + 8 * (r >> 2) + 4 * hi; }
__device__ __forceinline__ int perm32(int rho) { const int n = rho >> 4, i = rho & 15; return 8 * (i >> 2) + 4 * n + (i & 3); }
__device__ __forceinline__ float wave_sum(float v) {
#pragma unroll
    for (int o = 1; o < 64; o <<= 1) v += __shfl_xor(v, o);
    return v;
}
#define MFMA32(a, b, c) __builtin_amdgcn_mfma_f32_32x32x16_bf16(a, b, c, 0, 0, 0)
#define MFMA16(a, b, c) __builtin_amdgcn_mfma_f32_16x16x32_bf16(a, b, c, 0, 0, 0)

struct Args {
    const float* x; const int* pos; const float* norm_mix; const float* norm_ffn; const float* norm_final;
    const float* a_wqkv; const float* a_lq1; const float* a_lk1; const float* a_lq2; const float* a_lk2; const float* a_subln; const float* a_wo;
    const float* b_wqkv; const float* b_wo;
    const float* w_group; const float* b_group; const float* w_expert; const float* b_expert; const float* w_gate; const float* w_up; const float* w_down;
    float* out; unsigned char* ws;
    int ph_lo, ph_hi;
};

struct Frame {
    LAS unsigned char* lds;
    int tid, lane, wave, vcu, G;
    unsigned char* ws;
};

__device__ __forceinline__ void transpose_item(const float* W, int N, const float* g, bf16_t* WT, int dK, int k0, int n0, int drow0, LAS float* scr, int lane) {
#pragma unroll 8
    for (int i = 0; i < 32; ++i) { const int kk = 2 * i + (lane >> 5); float v = W[(size_t)(k0 + kk) * N + n0 + (lane & 31)]; if (g) v *= g[k0 + kk]; scr[kk * 33 + (lane & 31)] = v; }
    asm volatile("s_waitcnt lgkmcnt(0)" ::: "memory");
    const int c = lane & 7;
#pragma unroll
    for (int j = 0; j < 4; ++j) { const int n = (lane >> 3) + 8 * j; const LAS float* s = scr + (8 * c) * 33 + n;
        u32x4 o; o.x = cvtpk(s[0 * 33], s[1 * 33]); o.y = cvtpk(s[2 * 33], s[3 * 33]); o.z = cvtpk(s[4 * 33], s[5 * 33]); o.w = cvtpk(s[6 * 33], s[7 * 33]);
        *(u32x4*)(WT + (size_t)(drow0 + n) * dK + k0 + 8 * c) = o; }
    asm volatile("s_waitcnt lgkmcnt(0)" ::: "memory");
}
__device__ __forceinline__ void conv_moe_layer(Frame& F, const Args& A, int layer) {
    LAS float* scr = (LAS float*)(F.lds + F.wave * 16384);
    const int gw = F.vcu * NWAVES + F.wave, NGW = F.G * NWAVES;
    bf16_t* WGU = (bf16_t*)(F.ws + WS_WGU); bf16_t* WD = (bf16_t*)(F.ws + WS_WD);
    const float* g = A.norm_ffn + layer * DM;
    constexpr int I_G = (DM / 64) * (FF / 32);
    constexpr int I_D = (FF / 64) * (DM / 32);
    constexpr int NIT = NE * (2 * I_G + I_D);
    for (int it = gw; it < NIT; it += NGW) {
        const int e = it / (2 * I_G + I_D); int r = it % (2 * I_G + I_D);
        if (r < 2 * I_G) {
            const int up = r / I_G; r %= I_G; const int kb = r / (FF / 32), nb = r % (FF / 32); const int n0 = nb * 32;
            const float* W = (up ? A.w_up : A.w_gate) + ((size_t)layer * NE + e) * DM * FF;
            const int drow0 = (n0 >> 7) * 256 + up * 128 + (n0 & 127);
            transpose_item(W, FF, g, WGU + (size_t)e * 1024 * 1024, DM, kb * 64, n0, drow0, scr, F.lane);
        } else {
            r -= 2 * I_G; const int kb = r / (DM / 32), nb = r % (DM / 32);
            const float* W = A.w_down + ((size_t)layer * NE + e) * FF * DM;
            transpose_item(W, DM, nullptr, WD + (size_t)e * 1024 * 512, FF, kb * 64, nb * 32, nb * 32, scr, F.lane);
        }
    }
}

template <int MODE>
__device__ __forceinline__ void row_pass(Frame& F, const Args& A, const float* hin, float* hout) {
    const int gw = F.vcu * NWAVES + F.wave, NGW = F.G * NWAVES;
    bf16_t* HB = (bf16_t*)(F.ws + WS_HB); float* RSTD = (float*)(F.ws + WS_RSTD_IN);
    const unsigned* TS = (const unsigned*)(F.ws + WS_TOKSLOT); const bf16_t* Y = (const bf16_t*)(F.ws + WS_Y);
    const unsigned* cnt = (const unsigned*)(F.ws + WS_CTL) + CW_CNT + (MODE == 2 ? 32 : 0);
    for (int row = gw; row < T; row += NGW) {
        f32x4 v[4];
#pragma unroll
        for (int j = 0; j < 4; ++j) v[j] = *(const f32x4*)(hin + (size_t)row * DM + 4 * F.lane + 256 * j);
        if (MODE != 0) {
#pragma unroll
            for (int k = 0; k < 2; ++k) {
                const unsigned ts = TS[2 * row + k]; const int e = ts >> 16, slot = ts & 0xffff;
                int ps = 0;
                for (int i = 0; i < e; ++i) ps += (int)((cnt[i] + 255u) & ~255u);
                const bf16_t* yr = Y + (size_t)(ps + slot) * DM;
#pragma unroll
                for (int j = 0; j < 4; ++j) { const u32x2 w = *(const u32x2*)(yr + 4 * F.lane + 256 * j);
                    v[j].x += bflo(w.x); v[j].y += bfhi(w.x); v[j].z += bflo(w.y); v[j].w += bfhi(w.y); }
            }
        }
        float s = 0.f;
#pragma unroll
        for (int j = 0; j < 4; ++j) s += (v[j].x * v[j].x + v[j].y * v[j].y) + (v[j].z * v[j].z + v[j].w * v[j].w);
        const float rstd = __builtin_amdgcn_rsqf(wave_sum(s) * (1.f / DM) + EPS);
        if (MODE == 2) {
#pragma unroll
            for (int j = 0; j < 4; ++j) { const f32x4 gf = *(const f32x4*)(A.norm_final + 4 * F.lane + 256 * j); *(f32x4*)(hout + (size_t)row * DM + 4 * F.lane + 256 * j) = v[j] * rstd * gf; }
        } else {
            if (MODE == 1) {
#pragma unroll
                for (int j = 0; j < 4; ++j) *(f32x4*)(hout + (size_t)row * DM + 4 * F.lane + 256 * j) = v[j];
            }
#pragma unroll
            for (int j = 0; j < 4; ++j) { u32x2 w; w.x = cvtpk(v[j].x, v[j].y); w.y = cvtpk(v[j].z, v[j].w); *(u32x2*)(HB + (size_t)row * DM + 4 * F.lane + 256 * j) = w; }
            if (F.lane == 0) RSTD[row] = rstd;
        }
    }
}

__device__ __forceinline__ void p0_prologue(Frame& F, const Args& A) {
    LAS float* scr = (LAS float*)(F.lds + F.wave * 16384);
    const int gw = F.vcu * NWAVES + F.wave, NGW = F.G * NWAVES;
    bf16_t* WQKV = (bf16_t*)(F.ws + WS_WQKV); bf16_t* WO = (bf16_t*)(F.ws + WS_WO);
    constexpr int I_QKV = (DM / 64) * (3072 / 32), I_O = (DM / 64) * (DM / 32);
    constexpr int NIT = 2 * I_QKV + 2 * I_O;
    for (int it = gw; it < NIT; it += NGW) {
        int r = it;
        if (r < 2 * I_QKV) { const int l = r / I_QKV; r %= I_QKV; const int kb = r / 96, nb = r % 96;
            transpose_item(l ? A.b_wqkv : A.a_wqkv, 3072, A.norm_mix + l * DM, WQKV + (size_t)l * 3072 * 1024, DM, kb * 64, nb * 32, nb * 32, scr, F.lane); continue; }
        r -= 2 * I_QKV; { const int l = r / I_O; r %= I_O; const int kb = r / 32, nb = r % 32;
            transpose_item(l ? A.b_wo : A.a_wo, DM, nullptr, WO + (size_t)l * 1024 * 1024, DM, kb * 64, nb * 32, nb * 32, scr, F.lane); }
    }
    conv_moe_layer(F, A, 0);
    { bf16_t* WR = (bf16_t*)(F.ws + WS_WR);
      const int gt = (F.vcu * NWAVES + F.wave) * 64 + F.lane, NGT = F.G * NWAVES * 64;
      for (int i = gt; i < 2 * 64 * 1024; i += NGT) { const int l = i >> 16, j = (i >> 10) & 63, k = i & 1023;
          float w = 0.f; if (j < 32) w = A.w_expert[((size_t)l * DM + k) * NE + j]; else if (j < 36) w = A.w_group[((size_t)l * DM + k) * NG + (j - 32)];
          w *= A.norm_ffn[l * DM + k];
          const unsigned h = cvtpk(w, 0.f) & 0xffffu; const float rem = w - bf2f((unsigned short)h); const unsigned lo = cvtpk(rem, 0.f) & 0xffffu;
          WR[((size_t)(l * 2 + 0) * 64 + j) * 1024 + k] = (bf16_t)h; WR[((size_t)(l * 2 + 1) * 64 + j) * 1024 + k] = (bf16_t)lo; }
      float* RT = (float*)(F.ws + WS_ROPE);
      for (int i = gt; i < T * 8; i += NGT) { const int row = i >> 3, f = i & 7; const float invf = powf(500000.0f, -(float)f / 8.0f); const float ang = (float)A.pos[row] * invf;
          float sn, cs; sincosf(ang, &sn, &cs); RT[row * 16 + f] = cs; RT[row * 16 + 8 + f] = sn; }
    }
    row_pass<0>(F, A, A.x, nullptr);
}

struct Unit { int pm, pn, e, slot0; };
template <class Epi, class Sched>
__device__ __forceinline__ void gemm_simple(int K, const Sched& S, const Epi& E) {
    const int tid = threadIdx.x, wid = __builtin_amdgcn_readfirstlane(tid >> 6), lane = tid & 63, wr = wid >> 2, wc = wid & 3, fr = lane & 15, fq = lane >> 4;
    Unit u;
    for (int ui = 0; S.next(ui, u); ++ui) {
        f32x4 acc[2][2][4][2];
#pragma unroll
        for (int a = 0; a < 2; ++a)
#pragma unroll
            for (int b = 0; b < 2; ++b)
#pragma unroll
                for (int m = 0; m < 4; ++m)
#pragma unroll
                    for (int n = 0; n < 2; ++n) acc[a][b][m][n] = (f32x4){0.f, 0.f, 0.f, 0.f};
        unsigned aoff[2][4], boff[2][2];
        const char* Ab = (const char*)S.abase();
#pragma unroll
        for (int a = 0; a < 2; ++a)
#pragma unroll
            for (int m = 0; m < 4; ++m) aoff[a][m] = (unsigned)S.arow(u, a * 128 + wr * 64 + m * 16 + fr) * (unsigned)(K * 2) + fq * 16;
        const char* Bb = (const char*)S.bbase(u);
#pragma unroll
        for (int b = 0; b < 2; ++b)
#pragma unroll
            for (int n = 0; n < 2; ++n) boff[b][n] = (unsigned)(b * 128 + wc * 32 + perm32(n * 16 + fr)) * (unsigned)(K * 2) + fq * 16;
#pragma unroll 1
        for (int k0 = 0; k0 < K; k0 += 32) {
            bf16x8 af[2][4], bf[2][2];
            const char* Ak = Ab + k0 * 2; const char* Bk = Bb + k0 * 2;
#pragma unroll
            for (int a = 0; a < 2; ++a)
#pragma unroll
                for (int m = 0; m < 4; ++m) af[a][m] = *(const bf16x8*)(Ak + aoff[a][m]);
#pragma unroll
            for (int b = 0; b < 2; ++b)
#pragma unroll
                for (int n = 0; n < 2; ++n) bf[b][n] = *(const bf16x8*)(Bk + boff[b][n]);
#pragma unroll
            for (int a = 0; a < 2; ++a)
#pragma unroll
                for (int b = 0; b < 2; ++b)
#pragma unroll
                    for (int m = 0; m < 4; ++m)
#pragma unroll
                        for (int n = 0; n < 2; ++n) acc[a][b][m][n] = MFMA16(bf[b][n], af[a][m], acc[a][b][m][n]);
        }
        E(acc, u, wr, wc, fr, fq);
    }
}

struct DenseSched {
    const bf16_t* A; const bf16_t* Bt; int K, nM, nN, G, c;
    __device__ __forceinline__ bool next(int i, Unit& u) const { const int L = i * G + c; if (L >= nM * nN) return false; u.pm = L / nN; u.pn = L % nN; u.e = 0; u.slot0 = 0; return true; }
    __device__ __forceinline__ const bf16_t* abase() const { return A; }
    __device__ __forceinline__ int arow(const Unit& u, int r) const { return u.pm * 256 + r; }
    __device__ __forceinline__ const bf16_t* bbase(const Unit& u) const { return Bt + (size_t)(u.pn * 256) * K; }
};
struct MoeSched {
    const bf16_t* A; const bf16_t* Bt; size_t estride; int K, nN, G, c; bool gather;
    const unsigned* cnt; const int* rowtok;
    __device__ __forceinline__ bool next(int i, Unit& u) const {
        int L = i * G + c; int tile = L / nN; u.pn = L % nN; int pm = 0;
        for (int e = 0; e < NE; ++e) { const int nt = (int)((cnt[e] + 255u) >> 8); if (tile < nt) { u.e = e; u.slot0 = tile * 256; u.pm = pm + tile; return true; } tile -= nt; pm += nt; }
        return false;
    }
    __device__ __forceinline__ const bf16_t* abase() const { return A; }
    __device__ __forceinline__ int arow(const Unit& u, int r) const {
        if (gather) { const int slot = u.slot0 + r; return slot < (int)cnt[u.e] ? rowtok[u.e * ECAP + slot] : 0; }
        return u.pm * 256 + r;
    }
    __device__ __forceinline__ const bf16_t* bbase(const Unit& u) const { return Bt + (size_t)u.e * estride + (size_t)(u.pn * 256) * K; }
};

struct EpiQKV {
    bf16_t* Q; const float* rstd; const float* rope; float qscale;
    __device__ __forceinline__ void operator()(const f32x4 (&acc)[2][2][4][2], const Unit& u, int wr, int wc, int fr, int fq) const {
        const int colt = u.pn * 256, region = colt >> 10, cbase = colt & 1023;
        bf16_t* base = Q + (size_t)region * ((WS_K - WS_Q) / 2);
        const bool dorope = (rope != nullptr) && region < 2 && !(wc & 1);
        const float sc = region == 0 ? qscale : 1.f;
#pragma unroll
        for (int ai = 0; ai < 2; ++ai)
#pragma unroll
            for (int m = 0; m < 4; ++m) {
                const int row = u.pm * 256 + ai * 128 + wr * 64 + m * 16 + fr; const float rs = rstd[row];
                float cs[8], sn[8];
                if (dorope) { const f32x4 c0 = *(const f32x4*)(rope + row * 16), c1 = *(const f32x4*)(rope + row * 16 + 4), s0 = *(const f32x4*)(rope + row * 16 + 8), s1 = *(const f32x4*)(rope + row * 16 + 12);
#pragma unroll
                    for (int i = 0; i < 4; ++i) { cs[i] = c0[i]; cs[4 + i] = c1[i]; sn[i] = s0[i]; sn[4 + i] = s1[i]; } }
#pragma unroll
                for (int bj = 0; bj < 2; ++bj) {
                    float v[8];
#pragma unroll
                    for (int i = 0; i < 4; ++i) { v[i] = acc[ai][bj][m][0][i] * rs; v[4 + i] = acc[ai][bj][m][1][i] * rs; }
                    if (dorope) {
#pragma unroll
                        for (int i = 0; i < 8; ++i) { const float p = __shfl_xor(v[i], 16); if (fq == 0) v[i] = v[i] * cs[i] - p * sn[i]; else if (fq == 1) v[i] = v[i] * cs[i] + p * sn[i]; }
                    }
                    u32x4 w; w.x = cvtpk(v[0] * sc, v[1] * sc); w.y = cvtpk(v[2] * sc, v[3] * sc); w.z = cvtpk(v[4] * sc, v[5] * sc); w.w = cvtpk(v[6] * sc, v[7] * sc);
                    *(u32x4*)(base + (size_t)row * DM + cbase + bj * 128 + wc * 32 + 8 * fq) = w;
                }
            }
    }
};
struct EpiRes {
    const float* res; float* out;
    __device__ __forceinline__ void operator()(const f32x4 (&acc)[2][2][4][2], const Unit& u, int wr, int wc, int fr, int fq) const {
#pragma unroll
        for (int ai = 0; ai < 2; ++ai)
#pragma unroll
            for (int m = 0; m < 4; ++m) {
                const int row = u.pm * 256 + ai * 128 + wr * 64 + m * 16 + fr;
#pragma unroll
                for (int bj = 0; bj < 2; ++bj) { const size_t off = (size_t)row * DM + u.pn * 256 + bj * 128 + wc * 32 + 8 * fq;
                    const f32x4 r0 = *(const f32x4*)(res + off), r1 = *(const f32x4*)(res + off + 4);
                    *(f32x4*)(out + off) = r0 + acc[ai][bj][m][0]; *(f32x4*)(out + off + 4) = r1 + acc[ai][bj][m][1]; }
            }
    }
};
struct EpiGateUp {
    bf16_t* hid; const float* rstd; const unsigned* cnt; const int* rowtok;
    __device__ __forceinline__ void operator()(const f32x4 (&acc)[2][2][4][2], const Unit& u, int wr, int wc, int fr, int fq) const {
#pragma unroll
        for (int ai = 0; ai < 2; ++ai)
#pragma unroll
            for (int m = 0; m < 4; ++m) {
                const int r = ai * 128 + wr * 64 + m * 16 + fr; const int slot = u.slot0 + r; const int tok = slot < (int)cnt[u.e] ? rowtok[u.e * ECAP + slot] : 0; const float rs = rstd[tok];
                float h[8];
#pragma unroll
                for (int i = 0; i < 8; ++i) { const float g = acc[ai][0][m][i >> 2][i & 3] * rs, up = acc[ai][1][m][i >> 2][i & 3] * rs; h[i] = g / (1.f + __expf(-g)) * up; }
                u32x4 w; w.x = cvtpk(h[0], h[1]); w.y = cvtpk(h[2], h[3]); w.z = cvtpk(h[4], h[5]); w.w = cvtpk(h[6], h[7]);
                *(u32x4*)(hid + (size_t)(u.pm * 256 + r) * FF + u.pn * 128 + wc * 32 + 8 * fq) = w;
            }
    }
};
struct EpiDown {
    bf16_t* Y; const unsigned* cnt; const float* rowgate;
    __device__ __forceinline__ void operator()(const f32x4 (&acc)[2][2][4][2], const Unit& u, int wr, int wc, int fr, int fq) const {
#pragma unroll
        for (int ai = 0; ai < 2; ++ai)
#pragma unroll
            for (int m = 0; m < 4; ++m) {
                const int r = ai * 128 + wr * 64 + m * 16 + fr; const int slot = u.slot0 + r; const float gt = slot < (int)cnt[u.e] ? rowgate[u.e * ECAP + slot] : 0.f;
#pragma unroll
                for (int bj = 0; bj < 2; ++bj) { const f32x4 a0 = acc[ai][bj][m][0] * gt, a1 = acc[ai][bj][m][1] * gt;
                    u32x4 w; w.x = cvtpk(a0[0], a0[1]); w.y = cvtpk(a0[2], a0[3]); w.z = cvtpk(a1[0], a1[1]); w.w = cvtpk(a1[2], a1[3]);
                    *(u32x4*)(Y + (size_t)(u.pm * 256 + r) * DM + u.pn * 256 + bj * 128 + wc * 32 + 8 * fq) = w; }
            }
    }
};

__device__ __forceinline__ void qk_tile(f32x16& p0, f32x16& p1, const bf16_t* Kt, const bf16x8* qr, int r32, int hi) {
    p0 = (f32x16){}; p1 = (f32x16){};
    const bf16_t* kp = Kt + (size_t)r32 * DM + hi * 8; asm volatile("" : "+v"(kp));
#pragma unroll
    for (int d0 = 0; d0 < 4; ++d0) {
        const bf16x8 b0 = *(const bf16x8*)(kp + d0 * 16), b1 = *(const bf16x8*)(kp + 32 * DM + d0 * 16);
        p0 = MFMA32(b0, qr[d0], p0); p1 = MFMA32(b1, qr[d0], p1);
    }
}
typedef short v4i16_t __attribute__((ext_vector_type(4)));
typedef short s16x4 __attribute__((ext_vector_type(4)));
__device__ __forceinline__ s16x4 vtr(LAS const unsigned char* p) { return __builtin_bit_cast(s16x4, __builtin_amdgcn_ds_read_tr16_b64_v4i16((LAS v4i16_t*)p)); }
template <int ND>
__device__ __forceinline__ void pv_tile(f32x16* o, const f32x16& p0, const f32x16& p1, const bf16_t* Vt, LAS unsigned char* vs, int lane) {
    const int hi = lane >> 5;
    asm volatile("" ::: "memory");
#pragma unroll
    for (int i0 = 0; i0 < ND * 4; i0 += 4) {
        u32x4 t[4];
        const bf16_t* vp = Vt + (size_t)(lane / (ND * 4)) * DM + (lane % (ND * 4)) * 8; asm volatile("" : "+v"(vp));
#pragma unroll
        for (int i = 0; i < 4; ++i) t[i] = *(const u32x4*)(vp + (size_t)((i0 + i) * (64 / (ND * 4))) * DM);
        asm volatile("" : "+v"(t[0]), "+v"(t[1]), "+v"(t[2]), "+v"(t[3]));
#pragma unroll
        for (int i = 0; i < 4; ++i) { const int c = (i0 + i) * 64 + lane, row = c / (ND * 4), ch = c % (ND * 4); *(LAS u32x4*)(vs + (ch >> 2) * 4096 + row * 64 + (ch & 3) * 16) = t[i]; }
    }
    asm volatile("s_waitcnt lgkmcnt(0)" ::: "memory");
    u32x4 pw[4];
    pw[0] = (u32x4){cvtpk(p0[0], p0[1]), cvtpk(p0[2], p0[3]), cvtpk(p0[4], p0[5]), cvtpk(p0[6], p0[7])};
    pw[1] = (u32x4){cvtpk(p0[8], p0[9]), cvtpk(p0[10], p0[11]), cvtpk(p0[12], p0[13]), cvtpk(p0[14], p0[15])};
    pw[2] = (u32x4){cvtpk(p1[0], p1[1]), cvtpk(p1[2], p1[3]), cvtpk(p1[4], p1[5]), cvtpk(p1[6], p1[7])};
    pw[3] = (u32x4){cvtpk(p1[8], p1[9]), cvtpk(p1[10], p1[11]), cvtpk(p1[12], p1[13]), cvtpk(p1[14], p1[15])};
    LAS const unsigned char* vb = vs + ((lane >> 4) & 1) * 32 + (lane & 3) * 8 + (4 * hi + ((lane & 15) >> 2)) * 64;
#pragma unroll
    for (int d0 = 0; d0 < ND; ++d0) {
#pragma unroll
        for (int ks = 0; ks < 4; ++ks) {
            const s16x4 lo = vtr(vb + d0 * 4096 + ks * 1024), hh = vtr(vb + d0 * 4096 + ks * 1024 + 512);
            const bf16x8 vf = (bf16x8){lo[0], lo[1], lo[2], lo[3], hh[0], hh[1], hh[2], hh[3]};
            o[d0] = MFMA32(__builtin_bit_cast(bf16x8, pw[ks]), vf, o[d0]);
        }
    }
    asm volatile("s_waitcnt lgkmcnt(0)" ::: "memory");
}

__device__ __forceinline__ void diff_map(Frame& F, f32x16* o, const bf16_t* Q, const bf16_t* K, const bf16_t* V, size_t rb, int q0, int h, int mp) {
    const int lane = F.lane, r32 = lane & 31, hi = lane >> 5;
    LAS float* wsf = (LAS float*)(F.lds + 131072 + F.wave * 512);
    bf16x8 qr[4];
#pragma unroll
    for (int d0 = 0; d0 < 4; ++d0) qr[d0] = *(const bf16x8*)(Q + (rb + q0 + r32) * DM + h * 128 + mp * 64 + d0 * 16 + hi * 8);
    o[0] = (f32x16){}; o[1] = (f32x16){}; o[2] = (f32x16){}; o[3] = (f32x16){};
    float mrun = -1e30f, l = 0.f;
    const int nt = (q0 >> 6) + 1;
#pragma unroll 1
    for (int t = 0; t < nt; ++t) {
        const int key0 = t * 64; f32x16 p0, p1;
        qk_tile(p0, p1, K + (rb + key0) * DM + h * 128 + mp * 64, qr, r32, hi);
        if (t == nt - 1) { const int q = q0 + r32;
#pragma unroll
            for (int r = 0; r < 16; ++r) { const int kv = key0 + crow(r, hi); if (kv > q) p0[r] = -1e30f; if (kv + 32 > q) p1[r] = -1e30f; } }
        float mx = p0[0];
#pragma unroll
        for (int r = 1; r < 16; ++r) mx = fmaxf(mx, p0[r]);
#pragma unroll
        for (int r = 0; r < 16; ++r) mx = fmaxf(mx, p1[r]);
        mx = fmaxf(mx, __shfl_xor(mx, 32));
        const float mnew = fmaxf(mrun, mx), f = __builtin_amdgcn_exp2f(mrun - mnew); mrun = mnew;
        float rs = 0.f;
#pragma unroll
        for (int r = 0; r < 16; ++r) { p0[r] = __builtin_amdgcn_exp2f(p0[r] - mnew); p1[r] = __builtin_amdgcn_exp2f(p1[r] - mnew); rs += p0[r] + p1[r]; }
        l = l * f + rs;
        if (hi == 0) wsf[r32] = f;
        asm volatile("s_waitcnt lgkmcnt(0)" ::: "memory");
#pragma unroll
        for (int r = 0; r < 16; ++r) { const float fr_ = wsf[crow(r, hi)];
#pragma unroll
            for (int d0 = 0; d0 < 4; ++d0) o[d0][r] *= fr_; }
        asm volatile("s_waitcnt lgkmcnt(0)" ::: "memory");
        pv_tile<4>(o, p0, p1, V + (rb + key0) * DM + h * 128, F.lds + F.wave * 16384, lane);
    }
    l += __shfl_xor(l, 32);
    if (hi == 0) wsf[32 + r32] = 1.f / l;
    asm volatile("s_waitcnt lgkmcnt(0)" ::: "memory");
#pragma unroll
    for (int r = 0; r < 16; ++r) { const float rr = wsf[32 + crow(r, hi)];
#pragma unroll
        for (int d0 = 0; d0 < 4; ++d0) o[d0][r] *= rr; }
    asm volatile("s_waitcnt lgkmcnt(0)" ::: "memory");
}
__device__ __forceinline__ void attn_diff_simple(Frame& F, const Args& A) {
    const int lane = F.lane, r32 = lane & 31, hi = lane >> 5;
    const bf16_t* Q = (const bf16_t*)(F.ws + WS_Q); const bf16_t* K = (const bf16_t*)(F.ws + WS_K); const bf16_t* V = (const bf16_t*)(F.ws + WS_V); bf16_t* AO = (bf16_t*)(F.ws + WS_AO);
    LAS float* stg = (LAS float*)(F.lds + F.wave * 16384);
    const float d1 = A.a_lq1[lane] * A.a_lk1[lane], d2 = A.a_lq2[lane] * A.a_lk2[lane];
    const float lam = __expf(wave_sum(d1)) - __expf(wave_sum(d2)) + 0.2f;
    const f32x4 sl = *(const f32x4*)(A.a_subln + 4 * r32) * 0.8f;
    const int gw = F.vcu * NWAVES + F.wave, NGW = F.G * NWAVES;
#pragma unroll 1
    for (int it = gw; it < BATCH * 8 * 128; it += NGW) {
        const int bh = it & 63, b = bh >> 3, h = bh & 7; const int qi = it >> 6, i4 = qi >> 5, j = qi & 31;
        const int qb = (i4 == 0) ? 127 - j : (i4 == 1) ? j : (i4 == 2) ? 95 - j : 32 + j;
        const int q0 = qb * 32; const size_t rb = (size_t)b * SEQ;
        f32x16 o[4];
        diff_map(F, o, Q, K, V, rb, q0, h, 0);
#pragma unroll
        for (int r = 0; r < 16; ++r)
#pragma unroll
            for (int d0 = 0; d0 < 4; ++d0) stg[crow(r, hi) * 128 + d0 * 32 + r32] = o[d0][r];
        asm volatile("s_waitcnt lgkmcnt(0)" ::: "memory");
        float* park = A.out + (rb + q0 + hi) * DM + h * 128 + 4 * r32;
#pragma unroll 4
        for (int i = 0; i < 16; ++i) *(f32x4*)(park + (size_t)(2 * i) * DM) = *(const LAS f32x4*)(stg + (2 * i + hi) * 128 + 4 * r32);
        asm volatile("s_waitcnt lgkmcnt(0)" ::: "memory");
        diff_map(F, o, Q, K, V, rb, q0, h, 1);
#pragma unroll
        for (int r = 0; r < 16; ++r)
#pragma unroll
            for (int d0 = 0; d0 < 4; ++d0) stg[crow(r, hi) * 128 + d0 * 32 + r32] = o[d0][r];
        asm volatile("s_waitcnt lgkmcnt(0)" ::: "memory");
        bf16_t* ao = AO + (rb + q0 + hi) * DM + h * 128 + 4 * r32;
#pragma unroll 4
        for (int i = 0; i < 16; ++i) {
            const f32x4 o1 = *(const LAS f32x4*)(stg + (2 * i + hi) * 128 + 4 * r32), o0 = *(const f32x4*)(park + (size_t)(2 * i) * DM);
            const f32x4 d = o0 - lam * o1;
            float ss = (d[0] * d[0] + d[1] * d[1]) + (d[2] * d[2] + d[3] * d[3]);
#pragma unroll
            for (int o_ = 1; o_ < 32; o_ <<= 1) ss += __shfl_xor(ss, o_);
            const float rn = __builtin_amdgcn_rsqf(ss * (1.f / 128.f) + EPS);
            u32x2 w; w.x = cvtpk(d[0] * rn * sl[0], d[1] * rn * sl[1]); w.y = cvtpk(d[2] * rn * sl[2], d[3] * rn * sl[3]);
            *(u32x2*)(ao + (size_t)(2 * i) * DM) = w;
        }
        asm volatile("s_waitcnt lgkmcnt(0)" ::: "memory");
    }
}

__device__ __forceinline__ void attn_sb_simple(Frame& F, const Args& A) {
    const int lane = F.lane, r32 = lane & 31, hi = lane >> 5;
    const bf16_t* Q = (const bf16_t*)(F.ws + WS_Q); const bf16_t* K = (const bf16_t*)(F.ws + WS_K); const bf16_t* V = (const bf16_t*)(F.ws + WS_V); bf16_t* AO = (bf16_t*)(F.ws + WS_AO);
    const int gw = F.vcu * NWAVES + F.wave, NGW = F.G * NWAVES;
    for (int it = gw; it < BATCH * 16 * 128; it += NGW) {
        const int bh = it & 127, b = bh >> 4, h = bh & 15; const int qb = it >> 7;
        const int q0 = qb * 32; const size_t rb = (size_t)b * SEQ; const int q = q0 + r32;
        bf16x8 qr[4];
#pragma unroll
        for (int d0 = 0; d0 < 4; ++d0) qr[d0] = *(const bf16x8*)(Q + (rb + q0 + r32) * DM + h * 64 + d0 * 16 + hi * 8);
        f32x16 o[2]; o[0] = (f32x16){}; o[1] = (f32x16){};
        float R = 0.f;
#pragma unroll 1
        for (int t = q0 >> 6; t >= 0; --t) {
            const int key0 = t * 64; f32x16 p0, p1;
            qk_tile(p0, p1, K + (rb + key0) * DM + h * 64, qr, r32, hi);
            f32x16 L0, L1;
#pragma unroll
            for (int r = 0; r < 16; ++r) {
                { const float z = p0[r]; const bool valid = key0 + crow(r, hi) < q; const float sp = fmaxf(z, 0.f) + LN2 * __builtin_amdgcn_logf(1.f + __builtin_amdgcn_exp2f(-fabsf(z) * LOG2E)); L0[r] = valid ? -sp : 0.f; p0[r] = valid ? z - sp : -1e30f; }
                { const float z = p1[r]; const bool valid = key0 + 32 + crow(r, hi) < q; const float sp = fmaxf(z, 0.f) + LN2 * __builtin_amdgcn_logf(1.f + __builtin_amdgcn_exp2f(-fabsf(z) * LOG2E)); L1[r] = valid ? -sp : 0.f; p1[r] = valid ? z - sp : -1e30f; }
            }
            float gs[8], og[8];
#pragma unroll
            for (int i = 0; i < 4; ++i) { gs[i] = (L0[4 * i] + L0[4 * i + 1]) + (L0[4 * i + 2] + L0[4 * i + 3]); gs[4 + i] = (L1[4 * i] + L1[4 * i + 1]) + (L1[4 * i + 2] + L1[4 * i + 3]); }
#pragma unroll
            for (int i = 0; i < 8; ++i) og[i] = __shfl_xor(gs[i], 32);
            float tb[8]; float run = 0.f;
#pragma unroll
            for (int i = 7; i >= 0; --i) { tb[i] = R + run + (hi == 0 ? og[i] : 0.f); run += gs[i] + og[i]; }
#pragma unroll
            for (int i = 0; i < 4; ++i) {
                { const float s3 = tb[i], s2 = s3 + L0[4 * i + 3], s1 = s2 + L0[4 * i + 2], s0 = s1 + L0[4 * i + 1];
                  p0[4 * i + 3] = __builtin_amdgcn_exp2f((p0[4 * i + 3] + s3) * LOG2E); p0[4 * i + 2] = __builtin_amdgcn_exp2f((p0[4 * i + 2] + s2) * LOG2E);
                  p0[4 * i + 1] = __builtin_amdgcn_exp2f((p0[4 * i + 1] + s1) * LOG2E); p0[4 * i] = __builtin_amdgcn_exp2f((p0[4 * i] + s0) * LOG2E); }
                { const float s3 = tb[4 + i], s2 = s3 + L1[4 * i + 3], s1 = s2 + L1[4 * i + 2], s0 = s1 + L1[4 * i + 1];
                  p1[4 * i + 3] = __builtin_amdgcn_exp2f((p1[4 * i + 3] + s3) * LOG2E); p1[4 * i + 2] = __builtin_amdgcn_exp2f((p1[4 * i + 2] + s2) * LOG2E);
                  p1[4 * i + 1] = __builtin_amdgcn_exp2f((p1[4 * i + 1] + s1) * LOG2E); p1[4 * i] = __builtin_amdgcn_exp2f((p1[4 * i] + s0) * LOG2E); }
            }
            R += run;
            pv_tile<2>(o, p0, p1, V + (rb + key0) * DM + h * 64, F.lds + F.wave * 16384, lane);
            if (__all(R < -104.f)) break;
        }
        { LAS float* stg = (LAS float*)(F.lds + F.wave * 16384);
#pragma unroll
          for (int r = 0; r < 16; ++r)
#pragma unroll
              for (int d0 = 0; d0 < 2; ++d0) stg[crow(r, hi) * 64 + d0 * 32 + r32] = o[d0][r];
          asm volatile("s_waitcnt lgkmcnt(0)" ::: "memory");
          bf16_t* ao = AO + (rb + q0 + (lane >> 4)) * DM + h * 64 + 4 * (lane & 15);
#pragma unroll 4
          for (int i = 0; i < 8; ++i) { const f32x4 v = *(const LAS f32x4*)(stg + (4 * i + (lane >> 4)) * 64 + 4 * (lane & 15)); u32x2 w; w.x = cvtpk(v[0], v[1]); w.y = cvtpk(v[2], v[3]); *(u32x2*)(ao + (size_t)(4 * i) * DM) = w; }
          asm volatile("s_waitcnt lgkmcnt(0)" ::: "memory"); }
    }
}

__device__ __forceinline__ void router_phase(Frame& F, const Args& A, int layer, const float* h1) {
    const int lane = F.lane, r32 = lane & 31, hi = lane >> 5;
    LAS float* lg = (LAS float*)(F.lds + F.wave * 16384);
    bf16_t* HB = (bf16_t*)(F.ws + WS_HB); float* RSTD = (float*)(F.ws + WS_RSTD_FF);
    const bf16_t* WRh = (const bf16_t*)(F.ws + WS_WR) + (size_t)(layer * 2 + 0) * 64 * 1024; const bf16_t* WRl = (const bf16_t*)(F.ws + WS_WR) + (size_t)(layer * 2 + 1) * 64 * 1024;
    unsigned* cnt = (unsigned*)(F.ws + WS_CTL) + CW_CNT + layer * 32; int* rowtok = (int*)(F.ws + WS_ROWTOK); float* rowgate = (float*)(F.ws + WS_ROWGATE); unsigned* TS = (unsigned*)(F.ws + WS_TOKSLOT);
    const float* bg = A.b_group + layer * NG; const float* be = A.b_expert + layer * NE;
    const int gw = F.vcu * NWAVES + F.wave, NGW = F.G * NWAVES;
    for (int grp = gw; grp < T / 32; grp += NGW) {
        const int row = grp * 32 + r32;
        f32x16 a0 = (f32x16){}, a1 = (f32x16){}; float ssq = 0.f;
#pragma unroll 2
        for (int s = 0; s < 64; ++s) {
            const int k = 16 * s + 8 * hi;
            const f32x4 v0 = *(const f32x4*)(h1 + (size_t)row * DM + k), v1 = *(const f32x4*)(h1 + (size_t)row * DM + k + 4);
            ssq += (v0[0] * v0[0] + v0[1] * v0[1]) + (v0[2] * v0[2] + v0[3] * v0[3]) + (v1[0] * v1[0] + v1[1] * v1[1]) + (v1[2] * v1[2] + v1[3] * v1[3]);
            u32x4 ah; ah.x = cvtpk(v0[0], v0[1]); ah.y = cvtpk(v0[2], v0[3]); ah.z = cvtpk(v1[0], v1[1]); ah.w = cvtpk(v1[2], v1[3]);
            u32x4 al; al.x = cvtpk(v0[0] - bflo(ah.x), v0[1] - bfhi(ah.x)); al.y = cvtpk(v0[2] - bflo(ah.y), v0[3] - bfhi(ah.y)); al.z = cvtpk(v1[0] - bflo(ah.z), v1[1] - bfhi(ah.z)); al.w = cvtpk(v1[2] - bflo(ah.w), v1[3] - bfhi(ah.w));
            *(u32x4*)(HB + (size_t)row * DM + k) = ah;
            const bf16x8 bh0 = *(const bf16x8*)(WRh + (size_t)r32 * 1024 + k), bl0 = *(const bf16x8*)(WRl + (size_t)r32 * 1024 + k);
            const bf16x8 bh1 = *(const bf16x8*)(WRh + (size_t)(32 + r32) * 1024 + k), bl1 = *(const bf16x8*)(WRl + (size_t)(32 + r32) * 1024 + k);
            const bf16x8 ahv = __builtin_bit_cast(bf16x8, ah), alv = __builtin_bit_cast(bf16x8, al);
            a0 = MFMA32(ahv, bh0, a0); a0 = MFMA32(alv, bh0, a0); a0 = MFMA32(ahv, bl0, a0);
            a1 = MFMA32(ahv, bh1, a1); a1 = MFMA32(alv, bh1, a1); a1 = MFMA32(ahv, bl1, a1);
        }
        ssq += __shfl_xor(ssq, 32);
        const float rstd = __builtin_amdgcn_rsqf(ssq * (1.f / DM) + EPS);
#pragma unroll
        for (int r = 0; r < 16; ++r) { lg[crow(r, hi) * 65 + r32] = a0[r]; lg[crow(r, hi) * 65 + 32 + r32] = a1[r]; }
        asm volatile("s_waitcnt lgkmcnt(0)" ::: "memory");
        if (hi == 0) {
            RSTD[row] = rstd;
            const LAS float* lr = lg + r32 * 65;
            float gl[4];
#pragma unroll
            for (int j = 0; j < 4; ++j) gl[j] = lr[32 + j] * rstd + bg[j];
            int gi = 0; float gm = gl[0];
#pragma unroll
            for (int j = 1; j < 4; ++j) if (gl[j] > gm) { gm = gl[j]; gi = j; }
            float gsum = 0.f;
#pragma unroll
            for (int j = 0; j < 4; ++j) gsum += __expf(gl[j] - gm);
            const float gwt = 1.f / gsum;
            float el[8];
#pragma unroll
            for (int j = 0; j < 8; ++j) el[j] = lr[gi * 8 + j] * rstd + be[gi * 8 + j];
            int i1 = 0; float m1 = el[0];
#pragma unroll
            for (int j = 1; j < 8; ++j) if (el[j] > m1) { m1 = el[j]; i1 = j; }
            int i2 = -1; float m2 = -3.0e38f;
#pragma unroll
            for (int j = 0; j < 8; ++j) if (j != i1 && el[j] > m2) { m2 = el[j]; i2 = j; }
            const float p2 = __expf(m2 - m1), inv = 1.f / (1.f + p2);
            const float g1 = gwt * inv, g2 = gwt * p2 * inv;
            const int e1 = gi * 8 + i1, e2 = gi * 8 + i2;
            const unsigned s1 = atomicAdd(&cnt[e1], 1u), s2 = atomicAdd(&cnt[e2], 1u);
            rowtok[e1 * ECAP + s1] = row; rowgate[e1 * ECAP + s1] = g1; rowtok[e2 * ECAP + s2] = row; rowgate[e2 * ECAP + s2] = g2;
            TS[2 * row] = ((unsigned)e1 << 16) | s1; TS[2 * row + 1] = ((unsigned)e2 << 16) | s2;
        }
        asm volatile("s_waitcnt lgkmcnt(0)" ::: "memory");
    }
}

constexpr int NPHASE = 15;
__device__ __forceinline__ Frame make_frame(unsigned char* lds_raw, unsigned char* ws) {
    Frame F; int t_ = threadIdx.x; asm volatile("" : "+v"(t_)); int bx = blockIdx.x, G = gridDim.x; asm volatile("" : "+s"(bx), "+s"(G));
    F.lds = (LAS unsigned char*)lds_raw; F.tid = t_; F.lane = t_ & 63; F.wave = __builtin_amdgcn_readfirstlane(t_ >> 6);
    F.G = G; F.vcu = (G % 8 == 0) ? (bx % 8) * (G / 8) + bx / 8 : bx; F.ws = ws; return F;
}
#define PH_IN(k) (A.ph_lo <= (k) && (k) < A.ph_hi)
template <int LAYER>
__device__ __forceinline__ void layer_phases(unsigned char* lds_raw, const Args& A) {
    unsigned char* ws = A.ws; constexpr int P = 1 + 7 * LAYER;
    if (PH_IN(P + 0)) {
        Frame F = make_frame(lds_raw, ws);
        DenseSched S{(const bf16_t*)(ws + WS_HB), (const bf16_t*)(ws + WS_WQKV) + (size_t)LAYER * 3072 * 1024, DM, T / 256, 3072 / 256, F.G, F.vcu};
        EpiQKV E{(bf16_t*)(ws + WS_Q), (const float*)(ws + WS_RSTD_IN), LAYER == 0 ? (const float*)(ws + WS_ROPE) : nullptr, LAYER == 0 ? 0.125f * LOG2E : 0.125f};
        gemm_simple(DM, S, E);
    }
    if (PH_IN(P + 1)) { Frame F = make_frame(lds_raw, ws); if (LAYER == 0) attn_diff_simple(F, A); else attn_sb_simple(F, A); }
    if (PH_IN(P + 2)) {
        Frame F = make_frame(lds_raw, ws);
        DenseSched S{(const bf16_t*)(ws + WS_AO), (const bf16_t*)(ws + WS_WO) + (size_t)LAYER * 1024 * 1024, DM, T / 256, DM / 256, F.G, F.vcu};
        EpiRes E{LAYER == 0 ? A.x : A.out, A.out};
        gemm_simple(DM, S, E);
    }
    if (PH_IN(P + 3)) { Frame F = make_frame(lds_raw, ws); router_phase(F, A, LAYER, A.out); }
    if (PH_IN(P + 4)) {
        Frame F = make_frame(lds_raw, ws);
        const unsigned* cnt = (const unsigned*)(ws + WS_CTL) + CW_CNT + LAYER * 32; const int* rowtok = (const int*)(ws + WS_ROWTOK);
        MoeSched S{(const bf16_t*)(ws + WS_HB), (const bf16_t*)(ws + WS_WGU), (size_t)1024 * 1024, DM, 4, F.G, F.vcu, true, cnt, rowtok};
        EpiGateUp E{(bf16_t*)(ws + WS_HID), (const float*)(ws + WS_RSTD_FF), cnt, rowtok};
        gemm_simple(DM, S, E);
    }
    if (PH_IN(P + 5)) {
        Frame F = make_frame(lds_raw, ws);
        const unsigned* cnt = (const unsigned*)(ws + WS_CTL) + CW_CNT + LAYER * 32; const int* rowtok = (const int*)(ws + WS_ROWTOK);
        MoeSched S{(const bf16_t*)(ws + WS_HID), (const bf16_t*)(ws + WS_WD), (size_t)1024 * 512, FF, 4, F.G, F.vcu, false, cnt, rowtok};
        EpiDown E{(bf16_t*)(ws + WS_Y), cnt, (const float*)(ws + WS_ROWGATE)};
        gemm_simple(FF, S, E);
    }
    if (PH_IN(P + 6)) {
        Frame F = make_frame(lds_raw, ws);
        if (LAYER == 0) { row_pass<1>(F, A, A.out, A.out); conv_moe_layer(F, A, 1); }
        else row_pass<2>(F, A, A.out, A.out);
    }
}
__global__ void __launch_bounds__(NTHREADS, 2) hybrid_fwd(Args A) {
    extern __shared__ __attribute__((aligned(16))) unsigned char lds_raw[];
    if (PH_IN(0)) { Frame F = make_frame(lds_raw, A.ws); p0_prologue(F, A); }
    layer_phases<0>(lds_raw, A);
    layer_phases<1>(lds_raw, A);
}

extern "C" void kernel_launch(void* const* d_in, const int* in_sizes, int n_in, void* d_out, int out_size, void* d_ws, size_t ws_size, hipStream_t stream) {
    static int grid = 0;
    if (grid == 0) {
        if (n_in != 21 || in_sizes[0] != T * DM || out_size != T * DM || ws_size < WS_END) { fprintf(stderr, "kernel_launch: unexpected shapes / workspace (%d inputs, ws %zu)\n", n_in, ws_size); grid = -1; return; }
        int dev = 0, cus = 0;
        if (hipGetDevice(&dev) != hipSuccess || hipDeviceGetAttribute(&cus, hipDeviceAttributeMultiprocessorCount, dev) != hipSuccess) { grid = -1; return; }
        if (hipFuncSetAttribute((const void*)hybrid_fwd, hipFuncAttributeMaxDynamicSharedMemorySize, LDS_BYTES) != hipSuccess) { grid = -1; return; }
        grid = cus;
    }
    if (grid < 0) return;
    (void)hipMemsetAsync((char*)d_ws + WS_CTL, 0, CTL_ZERO_BYTES, stream);
    Args a{};
    a.x = (const float*)d_in[0]; a.pos = (const int*)d_in[1]; a.norm_mix = (const float*)d_in[2]; a.norm_ffn = (const float*)d_in[3]; a.norm_final = (const float*)d_in[4];
    a.a_wqkv = (const float*)d_in[5]; a.a_lq1 = (const float*)d_in[6]; a.a_lk1 = (const float*)d_in[7]; a.a_lq2 = (const float*)d_in[8]; a.a_lk2 = (const float*)d_in[9];
    a.a_subln = (const float*)d_in[10]; a.a_wo = (const float*)d_in[11]; a.b_wqkv = (const float*)d_in[12]; a.b_wo = (const float*)d_in[13];
    a.w_group = (const float*)d_in[14]; a.b_group = (const float*)d_in[15]; a.w_expert = (const float*)d_in[16]; a.b_expert = (const float*)d_in[17];
    a.w_gate = (const float*)d_in[18]; a.w_up = (const float*)d_in[19]; a.w_down = (const float*)d_in[20];
    a.out = (float*)d_out; a.ws = (unsigned char*)d_ws;
    for (int ph = 0; ph < NPHASE; ++ph) {
        a.ph_lo = ph; a.ph_hi = ph + 1;
        hipLaunchKernelGGL(hybrid_fwd, dim3(grid), dim3(NTHREADS), LDS_BYTES, stream, a);
    }
}
```

```cpp
#include <hip/hip_runtime.h>
#include <hip/hip_cooperative_groups.h>
#include <cstdint>
#include <cstdio>

#define LAS __attribute__((address_space(3)))
#define GAS __attribute__((address_space(1)))
typedef unsigned short bf16_t;
typedef short bf16x8 __attribute__((ext_vector_type(8)));
typedef float f32x4 __attribute__((ext_vector_type(4)));
typedef float f32x16 __attribute__((ext_vector_type(16)));
typedef unsigned u32x4 __attribute__((ext_vector_type(4)));
typedef unsigned u32x2 __attribute__((ext_vector_type(2)));
typedef float f32x2_t __attribute__((ext_vector_type(2)));
typedef __bf16 bf16x2_t __attribute__((ext_vector_type(2)));

constexpr int DM = 1024, BATCH = 8, SEQ = 4096, T = BATCH * SEQ;
constexpr int NE = 32, EPG = 8, NG = 4, FF = 512;
constexpr float EPS = 1e-6f;
constexpr float LOG2E = 1.4426950408889634f, LN2 = 0.6931471805599453f;
constexpr int NWAVES = 8, NTHREADS = 512;
constexpr int ECAP = 32768;
constexpr int MAXROWS = 73728;

constexpr size_t MiB = 1u << 20;
constexpr size_t WS_CTL = 0, CTL_ZERO_BYTES = 32768;
constexpr size_t WS_ROPE = 1 * MiB;
constexpr size_t WS_RSTD_IN = 3 * MiB;
constexpr size_t WS_RSTD_FF = 3 * MiB + 256 * 1024;
constexpr size_t WS_TOKSLOT = 3 * MiB + 512 * 1024;
constexpr size_t WS_ROWTOK = 4 * MiB;
constexpr size_t WS_ROWGATE = 8 * MiB;
constexpr size_t WS_ROWRS = 12 * MiB;
constexpr size_t WS_WR = 16 * MiB;
constexpr size_t WS_WQKV = 17 * MiB;
constexpr size_t WS_WO = 29 * MiB;
constexpr size_t WS_WGU = 33 * MiB;
constexpr size_t WS_WD = 97 * MiB;
constexpr size_t WS_HB = 129 * MiB;
constexpr size_t WS_Q = 193 * MiB, WS_K = 257 * MiB, WS_V = 321 * MiB;
constexpr size_t WS_Y = 193 * MiB;
constexpr size_t WS_AO = 385 * MiB;
constexpr size_t WS_HID = 449 * MiB;
constexpr size_t WS_END = 521 * MiB;
static_assert(WS_Y + (size_t)MAXROWS * 1024 * 2 <= WS_AO && WS_HID + (size_t)MAXROWS * 512 * 2 <= WS_END, "ws map");
#ifndef FUSE_MOE
#define FUSE_MOE 1
#endif
constexpr int CW_TILE = 2048;
constexpr int CW_CNT = 1024;

constexpr int LDS_BYTES = 147456;

__device__ __forceinline__ unsigned cvtpk(float lo, float hi) { f32x2_t v = {lo, hi}; bf16x2_t b = __builtin_convertvector(v, bf16x2_t); return __builtin_bit_cast(unsigned, b); }
__device__ __forceinline__ float bf2f(unsigned short b) { return __uint_as_float((unsigned)b << 16); }
__device__ __forceinline__ float bflo(unsigned w) { return __uint_as_float(w << 16); }
__device__ __forceinline__ float bfhi(unsigned w) { return __uint_as_float(w & 0xffff0000u); }
__device__ __forceinline__ int crow(int r, int hi) { return (r & 3) + 8 * (r >> 2) + 4 * hi; }
__device__ __forceinline__ int perm32(int rho) { const int n = rho >> 4, i = rho & 15; return 8 * (i >> 2) + 4 * n + (i & 3); }
__device__ __forceinline__ float wave_sum(float v) {
#pragma unroll
    for (int o = 1; o < 64; o <<= 1) v += __shfl_xor(v, o);
    return v;
}
__device__ __forceinline__ int lane_id() { return (int)__builtin_amdgcn_mbcnt_hi(~0u, __builtin_amdgcn_mbcnt_lo(~0u, 0u)); }
__device__ __forceinline__ int fresh_tid(int wave_s) { int z = 0; asm volatile("" : "+s"(wave_s), "+s"(z)); int t = wave_s * 64 + (int)__builtin_amdgcn_mbcnt_hi(~0u, __builtin_amdgcn_mbcnt_lo(~0u, (unsigned)z)); asm volatile("" : "+v"(t)); return t; }
#define MFMA32(a, b, c) __builtin_amdgcn_mfma_f32_32x32x16_bf16(a, b, c, 0, 0, 0)
#define MFMA16(a, b, c) __builtin_amdgcn_mfma_f32_16x16x32_bf16(a, b, c, 0, 0, 0)

struct Args {
    const float* x; const int* pos; const float* norm_mix; const float* norm_ffn; const float* norm_final;
    const float* a_wqkv; const float* a_lq1; const float* a_lk1; const float* a_lq2; const float* a_lk2; const float* a_subln; const float* a_wo;
    const float* b_wqkv; const float* b_wo;
    const float* w_group; const float* b_group; const float* w_expert; const float* b_expert; const float* w_gate; const float* w_up; const float* w_down;
    float* out; unsigned char* ws;
    int ph_lo, ph_hi;
};

struct Frame {
    LAS unsigned char* lds;
    int tid, lane, wave, vcu, G;
    unsigned char* ws;
};

__device__ __forceinline__ void transpose_item(const float* W, int N, const float* g, bf16_t* WT, int dK, int k0, int n0, int drow0, LAS float* scr, int lane) {
#pragma unroll 8
    for (int i = 0; i < 32; ++i) { const int kk = 2 * i + (lane >> 5); float v = W[(size_t)(k0 + kk) * N + n0 + (lane & 31)]; if (g) v *= g[k0 + kk]; scr[kk * 33 + (lane & 31)] = v; }
    asm volatile("s_waitcnt lgkmcnt(0)" ::: "memory");
    const int c = lane & 7;
#pragma unroll
    for (int j = 0; j < 4; ++j) { const int n = (lane >> 3) + 8 * j; const LAS float* s = scr + (8 * c) * 33 + n;
        u32x4 o; o.x = cvtpk(s[0 * 33], s[1 * 33]); o.y = cvtpk(s[2 * 33], s[3 * 33]); o.z = cvtpk(s[4 * 33], s[5 * 33]); o.w = cvtpk(s[6 * 33], s[7 * 33]);
        *(u32x4*)(WT + (size_t)(drow0 + n) * dK + k0 + 8 * c) = o; }
    asm volatile("s_waitcnt lgkmcnt(0)" ::: "memory");
}
struct ConvItem { const float* W; const float* g; bf16_t* WT; int N, dK, k0, n0, drow0; };
__device__ __forceinline__ ConvItem moe_item(const Args& A, unsigned char* ws, int layer, int it) {
    constexpr int I_G = (DM / 64) * (FF / 32), I_D = (FF / 64) * (DM / 32);
    ConvItem c; const int e = it / (2 * I_G + I_D); int r = it % (2 * I_G + I_D);
    if (r < 2 * I_G) { const int up = r / I_G; r %= I_G; const int kb = r / (FF / 32), nb = r % (FF / 32); const int n0 = nb * 32;
        c.W = (up ? A.w_up : A.w_gate) + ((size_t)layer * NE + e) * DM * FF; c.g = A.norm_ffn + layer * DM; c.WT = (bf16_t*)(ws + WS_WGU) + (size_t)e * 1024 * 1024;
        c.N = FF; c.dK = DM; c.k0 = kb * 64; c.n0 = n0; c.drow0 = (n0 >> 7) * 256 + ((n0 & 127) >> 5) * 64 + up * 32;
    } else { r -= 2 * I_G; const int kb = r / (DM / 32), nb = r % (DM / 32);
        c.W = A.w_down + ((size_t)layer * NE + e) * FF * DM; c.g = nullptr; c.WT = (bf16_t*)(ws + WS_WD) + (size_t)e * 1024 * 512;
        c.N = DM; c.dK = FF; c.k0 = kb * 64; c.n0 = nb * 32; c.drow0 = nb * 32; }
    return c;
}
constexpr int MOE_CONV_ITEMS = NE * 3 * 256;
__device__ __forceinline__ void conv_load(const ConvItem& c, f32x4 (&x)[8], int lane) {
    const float* p = c.W + (size_t)(c.k0 + (lane >> 3)) * c.N + c.n0 + (lane & 7) * 4;
#pragma unroll
    for (int i = 0; i < 8; ++i) x[i] = __builtin_nontemporal_load((const f32x4*)(p + (size_t)(8 * i) * c.N));
}
__device__ __forceinline__ void conv_store(const ConvItem& c, const f32x4 (&x)[8], LAS float* scr, int lane) {
#pragma unroll
    for (int i = 0; i < 8; ++i) { const int kk = 8 * i + (lane >> 3); const float gv = c.g ? c.g[c.k0 + kk] : 1.f; LAS float* d = scr + kk * 33 + (lane & 7) * 4;
        d[0] = x[i][0] * gv; d[1] = x[i][1] * gv; d[2] = x[i][2] * gv; d[3] = x[i][3] * gv; }
    asm volatile("s_waitcnt lgkmcnt(0)" ::: "memory");
    const int cc = lane & 7;
#pragma unroll
    for (int j = 0; j < 4; ++j) { const int n = (lane >> 3) + 8 * j; const LAS float* sp = scr + (8 * cc) * 33 + n;
        u32x4 o; o.x = cvtpk(sp[0 * 33], sp[1 * 33]); o.y = cvtpk(sp[2 * 33], sp[3 * 33]); o.z = cvtpk(sp[4 * 33], sp[5 * 33]); o.w = cvtpk(sp[6 * 33], sp[7 * 33]);
        __builtin_nontemporal_store(o, (u32x4*)(c.WT + (size_t)(c.drow0 + n) * c.dK + c.k0 + 8 * cc)); }
    asm volatile("s_waitcnt lgkmcnt(0)" ::: "memory");
}
__device__ __forceinline__ void conv_moe_range(const Args& A, unsigned char* ws, int layer, LAS float* scr, int lane, int gw, int NGW) {
    if (gw >= MOE_CONV_ITEMS) return;
    f32x4 x[8], y[8];
    ConvItem c = moe_item(A, ws, layer, gw);
    conv_load(c, x, lane);
#pragma unroll 1
    for (int it = gw; it < MOE_CONV_ITEMS; it += NGW) {
        const int nx = it + NGW; ConvItem cn = c;
        if (nx < MOE_CONV_ITEMS) { cn = moe_item(A, ws, layer, nx); conv_load(cn, y, lane); }
        conv_store(c, x, scr, lane);
#pragma unroll
        for (int i = 0; i < 8; ++i) x[i] = y[i];
        c = cn;
    }
}
__device__ __forceinline__ void conv_moe_layer(Frame& F, const Args& A, int layer) {
    conv_moe_range(A, F.ws, layer, (LAS float*)(F.lds + F.wave * 16384), F.lane, F.vcu * NWAVES + F.wave, F.G * NWAVES);
}

template <int MODE>
__device__ __forceinline__ void row_pass(Frame& F, const Args& A, const float* xin, float* hout) {
    const int gw = F.vcu * NWAVES + F.wave, NGW = F.G * NWAVES, lane = F.lane;
    bf16_t* HB = (bf16_t*)(F.ws + WS_HB); float* RSTD = (float*)(F.ws + WS_RSTD_IN);
    const unsigned* TS = (const unsigned*)(F.ws + WS_TOKSLOT); const bf16_t* Y = (const bf16_t*)(F.ws + WS_Y);
    const unsigned* cnt = (const unsigned*)(F.ws + WS_CTL) + CW_CNT + (MODE == 2 ? 32 : 0);
    unsigned excl = 0;
    if (MODE != 0) { const unsigned pad = lane < 32 ? ((cnt[lane & 31] + 255u) & ~255u) : 0u; unsigned incl = pad;
#pragma unroll
        for (int o = 1; o < 32; o <<= 1) { const unsigned t = __shfl_up(incl, o); if (lane >= o) incl += t; }
        excl = incl - pad; }
    f32x4 gf[4];
    if (MODE == 2) {
#pragma unroll
        for (int j = 0; j < 4; ++j) gf[j] = *(const f32x4*)(A.norm_final + 4 * lane + 256 * j);
    }
    for (int row0 = gw; row0 < T; row0 += 2 * NGW) {
        f32x4 v[2][4]; u32x2 hb[2][4]; u32x2 y[2][2][4]; bool ok[2];
#pragma unroll
        for (int q = 0; q < 2; ++q) { const int row = row0 + q * NGW; ok[q] = row < T;
            if (ok[q]) {
                if (MODE == 0) {
#pragma unroll
                    for (int j = 0; j < 4; ++j) v[q][j] = __builtin_nontemporal_load((const f32x4*)(xin + (size_t)row * DM + 4 * lane + 256 * j));
                } else {
#pragma unroll
                    for (int j = 0; j < 4; ++j) hb[q][j] = *(const u32x2*)(HB + (size_t)row * DM + 4 * lane + 256 * j);
#pragma unroll
                    for (int k = 0; k < 2; ++k) { const unsigned ts = __builtin_amdgcn_readfirstlane(TS[2 * row + k]); const int e = ts >> 16, slot = ts & 0xffff;
                        const unsigned ps = __builtin_amdgcn_readlane(excl, e);
                        const bf16_t* yr = Y + (size_t)(ps + slot) * DM;
#pragma unroll
                        for (int j = 0; j < 4; ++j) y[q][k][j] = __builtin_nontemporal_load((const u32x2*)(yr + 4 * lane + 256 * j)); }
                }
            }
        }
#pragma unroll
        for (int q = 0; q < 2; ++q) if (ok[q]) { const int row = row0 + q * NGW;
            if (MODE != 0) {
#pragma unroll
                for (int j = 0; j < 4; ++j) { const u32x2 w = hb[q][j]; v[q][j].x = bflo(w.x); v[q][j].y = bfhi(w.x); v[q][j].z = bflo(w.y); v[q][j].w = bfhi(w.y); }
#pragma unroll
                for (int k = 0; k < 2; ++k)
#pragma unroll
                    for (int j = 0; j < 4; ++j) { const u32x2 w = y[q][k][j]; v[q][j].x += bflo(w.x); v[q][j].y += bfhi(w.x); v[q][j].z += bflo(w.y); v[q][j].w += bfhi(w.y); }
            }
            float s = 0.f;
#pragma unroll
            for (int j = 0; j < 4; ++j) s += (v[q][j].x * v[q][j].x + v[q][j].y * v[q][j].y) + (v[q][j].z * v[q][j].z + v[q][j].w * v[q][j].w);
            const float rstd = __builtin_amdgcn_rsqf(wave_sum(s) * (1.f / DM) + EPS);
            if (MODE == 2) {
#pragma unroll
                for (int j = 0; j < 4; ++j) __builtin_nontemporal_store(v[q][j] * rstd * gf[j], (f32x4*)(hout + (size_t)row * DM + 4 * lane + 256 * j));
            } else {
#pragma unroll
                for (int j = 0; j < 4; ++j) { u32x2 w; w.x = cvtpk(v[q][j].x, v[q][j].y); w.y = cvtpk(v[q][j].z, v[q][j].w); *(u32x2*)(HB + (size_t)row * DM + 4 * lane + 256 * j) = w; }
                if (lane == 0) RSTD[row] = rstd;
            }
        }
    }
}

__device__ __forceinline__ void p0_prologue(Frame& F, const Args& A) {
    LAS float* scr = (LAS float*)(F.lds + F.wave * 16384);
    const int gw = F.vcu * NWAVES + F.wave, NGW = F.G * NWAVES;
    bf16_t* WQKV = (bf16_t*)(F.ws + WS_WQKV); bf16_t* WO = (bf16_t*)(F.ws + WS_WO);
    constexpr int I_QKV = (DM / 64) * (3072 / 32), I_O = (DM / 64) * (DM / 32);
    constexpr int NIT = 2 * I_QKV + 2 * I_O;
    {
        auto item = [&](int it) { ConvItem c; int r = it;
            if (r < 2 * I_QKV) { const int l = r / I_QKV; r %= I_QKV; const int kb = r / 96, nb = r % 96; c.W = l ? A.b_wqkv : A.a_wqkv; c.g = A.norm_mix + l * DM; c.WT = WQKV + (size_t)l * 3072 * 1024; c.N = 3072; c.dK = DM; c.k0 = kb * 64; c.n0 = nb * 32; c.drow0 = nb * 32; }
            else { r -= 2 * I_QKV; const int l = r / I_O; r %= I_O; const int kb = r / 32, nb = r % 32; c.W = l ? A.b_wo : A.a_wo; c.g = nullptr; c.WT = WO + (size_t)l * 1024 * 1024; c.N = DM; c.dK = DM; c.k0 = kb * 64; c.n0 = nb * 32; c.drow0 = nb * 32; }
            return c; };
        if (gw < NIT) { f32x4 xx[8], yy[8]; ConvItem c = item(gw); conv_load(c, xx, F.lane);
#pragma unroll 1
            for (int it = gw; it < NIT; it += NGW) { const int nx = it + NGW; ConvItem cn = c; if (nx < NIT) { cn = item(nx); conv_load(cn, yy, F.lane); }
                conv_store(c, xx, scr, F.lane);
#pragma unroll
                for (int i = 0; i < 8; ++i) xx[i] = yy[i];
                c = cn; } }
    }
    conv_moe_layer(F, A, 0);
    { bf16_t* WR = (bf16_t*)(F.ws + WS_WR);
      const int gt = (F.vcu * NWAVES + F.wave) * 64 + F.lane, NGT = F.G * NWAVES * 64;
      for (int i = gt; i < 2 * 64 * 1024; i += NGT) { const int l = i >> 16, j = (i >> 10) & 63, k = i & 1023;
          float w = 0.f; if (j < 32) w = A.w_expert[((size_t)l * DM + k) * NE + j]; else if (j < 36) w = A.w_group[((size_t)l * DM + k) * NG + (j - 32)];
          w *= A.norm_ffn[l * DM + k];
          const unsigned h = cvtpk(w, 0.f) & 0xffffu; const float rem = w - bf2f((unsigned short)h); const unsigned lo = cvtpk(rem, 0.f) & 0xffffu;
          WR[((size_t)(l * 2 + 0) * 64 + j) * 1024 + k] = (bf16_t)h; WR[((size_t)(l * 2 + 1) * 64 + j) * 1024 + k] = (bf16_t)lo; }
      float* RT = (float*)(F.ws + WS_ROPE);
      for (int i = gt; i < T * 8; i += NGT) { const int row = i >> 3, f = i & 7; const float invf = powf(500000.0f, -(float)f / 8.0f); const float ang = (float)A.pos[row] * invf;
          float sn, cs; sincosf(ang, &sn, &cs); RT[row * 16 + f] = cs; RT[row * 16 + 8 + f] = sn; }
    }
    row_pass<0>(F, A, A.x, nullptr);
}

struct Unit { int pm, pn, e, slot0; };
template <class Epi, class Sched>
__device__ __forceinline__ void gemm_simple(const int tid, int K, const Sched& S, const Epi& E) {
    const int wid = __builtin_amdgcn_readfirstlane(tid >> 6), lane = tid & 63, wr = wid >> 2, wc = wid & 3, fr = lane & 15, fq = lane >> 4;
    Unit u;
    for (int ui = 0; S.next(ui, u); ++ui) {
        f32x4 acc[2][2][4][2];
#pragma unroll
        for (int a = 0; a < 2; ++a)
#pragma unroll
            for (int b = 0; b < 2; ++b)
#pragma unroll
                for (int m = 0; m < 4; ++m)
#pragma unroll
                    for (int n = 0; n < 2; ++n) acc[a][b][m][n] = (f32x4){0.f, 0.f, 0.f, 0.f};
        unsigned aoff[2][4], boff[2][2];
        const char* Ab = (const char*)S.abase();
#pragma unroll
        for (int a = 0; a < 2; ++a)
#pragma unroll
            for (int m = 0; m < 4; ++m) aoff[a][m] = (unsigned)S.arow(u, a * 128 + wr * 64 + m * 16 + fr) * (unsigned)(K * 2) + fq * 16;
        const char* Bb = (const char*)S.bbase(u);
#pragma unroll
        for (int b = 0; b < 2; ++b)
#pragma unroll
            for (int n = 0; n < 2; ++n) boff[b][n] = (unsigned)(wc * 64 + b * 32 + perm32(n * 16 + fr)) * (unsigned)(K * 2) + fq * 16;
#pragma unroll 1
        for (int k0 = 0; k0 < K; k0 += 32) {
            bf16x8 af[2][4], bf[2][2];
            const char* Ak = Ab + k0 * 2; const char* Bk = Bb + k0 * 2;
#pragma unroll
            for (int a = 0; a < 2; ++a)
#pragma unroll
                for (int m = 0; m < 4; ++m) af[a][m] = *(const bf16x8*)(Ak + aoff[a][m]);
#pragma unroll
            for (int b = 0; b < 2; ++b)
#pragma unroll
                for (int n = 0; n < 2; ++n) bf[b][n] = *(const bf16x8*)(Bk + boff[b][n]);
#pragma unroll
            for (int a = 0; a < 2; ++a)
#pragma unroll
                for (int b = 0; b < 2; ++b)
#pragma unroll
                    for (int m = 0; m < 4; ++m)
#pragma unroll
                        for (int n = 0; n < 2; ++n) acc[a][b][m][n] = MFMA16(bf[b][n], af[a][m], acc[a][b][m][n]);
        }
        E(acc, u, wr, wc, fr, fq);
    }
}


constexpr int BK = 64, HALF = 128, HTB = HALF * BK * 2;
__device__ __forceinline__ int lds_byte(int r, int c) { const int q = (r >> 2) & 3, pos = ((c >> 3) & 3) ^ ((4 - q) & 3); return (r >> 3) * 1024 + (c >> 5) * 512 + (r & 7) * 64 + pos * 16 + (c & 7) * 2; }
__device__ __forceinline__ void stage_rc(int b, int& R, int& C) { const int ch = b >> 10, ks = (b >> 9) & 1, r7 = (b >> 6) & 7, pos = (b >> 4) & 3; R = ch * 8 + r7; const int q = (R >> 2) & 3; C = ks * 32 + ((pos ^ ((4 - q) & 3)) << 3); }
template <class Epi, class Sched, bool GATHER>
__device__ __forceinline__ void gemm_fast(const int tid, LAS unsigned char* lds, const int K, const Sched& S, const Epi& E) {
    const int wid = __builtin_amdgcn_readfirstlane(tid >> 6), lane = tid & 63, wr = wid >> 2, wc = wid & 3, fr = lane & 15, fq = lane >> 4;
    const int nt = K / BK;
    unsigned voffA[2], voffB[2]; int RA[2], CA[2];
#pragma unroll
    for (int i = 0; i < 2; ++i) { int R, C; stage_rc(tid * 16 + i * 8192, R, C); const int Rb = (R >> 5) * 64 + perm32(R & 31); RA[i] = R; CA[i] = C;
        voffA[i] = (unsigned)(R * K + C) * 2u; voffB[i] = (unsigned)(Rb * K + C) * 2u; }
    const size_t kstep = (size_t)(BK * 2), hstep = (size_t)HALF * K * 2, hstepB = (size_t)32 * K * 2;
    const unsigned ldsw = (unsigned)wid * 1024u;
    const int aoff = lds_byte(wr * 64 + fr, fq * 8), boff = lds_byte(wc * 32 + fr, fq * 8);
#define G_SA(b, h) (((b) * 2 + (h)) * HTB)
#define G_SB(b, h) ((4 + (b) * 2 + (h)) * HTB)
#define G_STAGE(bufoff, gbase, v0, v1) do { \
        __builtin_amdgcn_global_load_lds((const unsigned*)((const char*)(gbase) + (v0)), (LAS unsigned*)(lds + (bufoff) + ldsw), 16, 0, 0); \
        __builtin_amdgcn_global_load_lds((const unsigned*)((const char*)(gbase) + (v1)), (LAS unsigned*)(lds + (bufoff) + ldsw + 8192), 16, 0, 0); } while (0)
#define G_STAGE_B(bufoff, gbase) G_STAGE(bufoff, gbase, voffB[0], voffB[1])
#define G_STAGE_A(bufoff, X, h, koff) do { if (GATHER) { G_STAGE(bufoff, Abase + (koff), (X) ? gn[h][0] : ga[h][0], (X) ? gn[h][1] : ga[h][1]); } \
        else { G_STAGE(bufoff, ((X) ? nA : cA) + (h) * hstep + (koff), voffA[0], voffA[1]); } } while (0)
#define G_STAGE_A_RT(bufoff, L, h, koff) do { if (GATHER) { const unsigned o0_ = (L) ? gn[h][0] : ga[h][0], o1_ = (L) ? gn[h][1] : ga[h][1]; G_STAGE(bufoff, Abase + (koff), o0_, o1_); } \
        else { G_STAGE(bufoff, ((L) ? nA : cA) + (h) * hstep + (koff), voffA[0], voffA[1]); } } while (0)
#define G_LDA(dst, b, h) do { _Pragma("unroll") for (int m = 0; m < 4; ++m) _Pragma("unroll") for (int k = 0; k < 2; ++k) dst[m][k] = *(const LAS bf16x8*)(lds + G_SA(b, h) + aoff + m * 2048 + k * 512); } while (0)
#define G_LDB(dst, b, h) do { _Pragma("unroll") for (int n = 0; n < 2; ++n) _Pragma("unroll") for (int k = 0; k < 2; ++k) dst[n][k] = *(const LAS bf16x8*)(lds + G_SB(b, h) + boff + n * 2048 + k * 512); } while (0)
#define G_MMA(ai, bj, At, Bt) do { __builtin_amdgcn_s_setprio(1); _Pragma("unroll") for (int m = 0; m < 4; ++m) _Pragma("unroll") for (int n = 0; n < 2; ++n) _Pragma("unroll") for (int k = 0; k < 2; ++k) \
        acc[ai][bj][m][n] = MFMA16(Bt[n][k], At[m][k], acc[ai][bj][m][n]); __builtin_amdgcn_s_setprio(0); } while (0)
#define G_WAIT_V(n) asm volatile("s_waitcnt vmcnt(" #n ")" ::: "memory")
#define G_WAIT_L(n) asm volatile("s_waitcnt lgkmcnt(" #n ")" ::: "memory")
#define G_BAR __builtin_amdgcn_s_barrier()
#define G_SCHED __builtin_amdgcn_sched_barrier(0)
    Unit cur, nxt; int ui = 0;
    if (!S.next(0, cur)) return;
    f32x4 acc[2][2][4][2];
#pragma unroll
    for (int a = 0; a < 2; ++a)
#pragma unroll
        for (int b = 0; b < 2; ++b)
#pragma unroll
            for (int m = 0; m < 4; ++m)
#pragma unroll
                for (int n = 0; n < 2; ++n) acc[a][b][m][n] = (f32x4){0.f, 0.f, 0.f, 0.f};
    bf16x8 At[4][2], B0[2][2], B1[2][2];
    const char* const Abase = (const char*)S.abase();
    unsigned ga[2][2], gn[2][2];
    const char* cA = GATHER ? Abase : (const char*)S.a_tile(cur); const char* cB = (const char*)S.b_tile(cur);
    if (GATHER) {
#pragma unroll
        for (int h = 0; h < 2; ++h)
#pragma unroll
            for (int i = 0; i < 2; ++i) { ga[h][i] = (unsigned)S.tok(cur, h * HALF + RA[i]) * (unsigned)(K * 2) + (unsigned)CA[i] * 2u; gn[h][i] = ga[h][i]; }
    }
    const char* nA = cA; const char* nB = cB;
    G_STAGE_B(G_SB(0, 0), cB); G_STAGE_B(G_SB(0, 1), cB + hstepB); G_STAGE_A(G_SA(0, 0), 0, 0, 0); G_STAGE_A(G_SA(0, 1), 0, 1, 0);
    if (wr == 1) G_BAR;
    G_WAIT_V(2); G_BAR;
    G_STAGE_B(G_SB(1, 0), cB + kstep); G_STAGE_A(G_SA(1, 0), 0, 0, kstep); G_STAGE_B(G_SB(1, 1), cB + hstepB + kstep);
    G_WAIT_V(6); G_BAR;
    for (;;) {
        const bool has_next = S.next(ui + 1, nxt);
        nA = has_next ? (GATHER ? Abase : (const char*)S.a_tile(nxt)) : cA; nB = has_next ? (const char*)S.b_tile(nxt) : cB;
        for (int t = 0; t < nt; t += 2) {
            const bool last = (t == nt - 2);
            if (GATHER && last && has_next) {
#pragma unroll
                for (int h = 0; h < 2; ++h)
#pragma unroll
                    for (int i = 0; i < 2; ++i) gn[h][i] = (unsigned)S.tok(nxt, h * HALF + RA[i]) * (unsigned)(K * 2) + (unsigned)CA[i] * 2u;
            }
            const size_t k1 = (size_t)(t + 1) * kstep, k2 = last ? 0 : (size_t)(t + 2) * kstep, k3 = k2 + kstep;
            const char* b2 = (last ? nB : cB) + k2; const char* b3 = b2 + kstep;
            G_LDB(B0, 0, 0); G_LDB(B1, 0, 1); G_SCHED; G_LDA(At, 0, 0); G_STAGE_A(G_SA(1, 1), 0, 1, k1);
            G_WAIT_V(8); G_WAIT_L(0); G_BAR; G_MMA(0, 0, At, B0); G_MMA(0, 1, At, B1); G_BAR; G_SCHED;
            G_LDA(At, 0, 1); G_STAGE_B(G_SB(0, 0), b2); G_STAGE_B(G_SB(0, 1), b2 + hstepB); G_STAGE_A_RT(G_SA(0, 0), last, 0, k2);
            G_WAIT_V(8); G_WAIT_L(0); G_BAR; G_MMA(1, 0, At, B0); G_MMA(1, 1, At, B1); G_BAR; G_SCHED;
            G_LDB(B0, 1, 0); G_LDB(B1, 1, 1); G_SCHED; G_LDA(At, 1, 0); G_STAGE_A_RT(G_SA(0, 1), last, 1, k2);
            G_WAIT_V(8); G_WAIT_L(0); G_BAR; G_MMA(0, 0, At, B0); G_MMA(0, 1, At, B1); G_BAR; G_SCHED;
            G_LDA(At, 1, 1); G_STAGE_B(G_SB(1, 0), b3); G_STAGE_B(G_SB(1, 1), b3 + hstepB); G_STAGE_A_RT(G_SA(1, 0), last, 0, k3);
            G_WAIT_V(8); G_WAIT_L(0); G_BAR; G_MMA(1, 0, At, B0); G_MMA(1, 1, At, B1); G_BAR; G_SCHED;
        }
        if (wr == 0) G_BAR;
        E(acc, cur, wr, wc, fr, fq);
        if (Epi::SIGNAL) { G_WAIT_V(0); G_BAR; if (tid == 0) E.signal(cur); }
        if (!has_next) break;
        cur = nxt; cA = nA; cB = nB; ++ui;
        if (GATHER) {
#pragma unroll
            for (int h = 0; h < 2; ++h)
#pragma unroll
                for (int i = 0; i < 2; ++i) ga[h][i] = gn[h][i];
        }
        if (wr == 1) G_BAR;
    }
    G_WAIT_V(0);
    G_BAR;
#undef G_SA
#undef G_SB
#undef G_STAGE
#undef G_STAGE_B
#undef G_STAGE_A
#undef G_STAGE_A_RT
#undef G_LDA
#undef G_LDB
#undef G_MMA
#undef G_WAIT_V
#undef G_WAIT_L
#undef G_BAR
#undef G_SCHED
}

struct DenseFast {
    const bf16_t* A; const bf16_t* Bt; int K, nM, nN, G, c;
    __device__ __forceinline__ bool next(int i, Unit& u) const {
        const int nwg = nM * nN; const int L = i * G + c; if (L >= nwg) return false;
        int wgid = L; { const int q = nwg / 8, r = nwg % 8, xcd = wgid % 8, off = wgid / 8; wgid = (xcd < r ? xcd * (q + 1) : r * (q + 1) + (xcd - r) * q) + off; }
        const int nig = 8 * nN, gid = wgid / nig, fm = gid * 8, gsz = (nM - fm) < 8 ? (nM - fm) : 8;
        u.pm = fm + ((wgid % nig) % gsz); u.pn = (wgid % nig) / gsz; u.e = 0; u.slot0 = 0; return true;
    }
    __device__ __forceinline__ const bf16_t* abase() const { return A; }
    __device__ __forceinline__ const bf16_t* a_tile(const Unit& u) const { return A + (size_t)(u.pm * 256) * K; }
    __device__ __forceinline__ const bf16_t* b_tile(const Unit& u) const { return Bt + (size_t)(u.pn * 256) * K; }
    __device__ __forceinline__ int tok(const Unit& u, int r) const { return u.pm * 256 + r; }
    __device__ __forceinline__ int arow(const Unit& u, int r) const { return u.pm * 256 + r; }
    __device__ __forceinline__ const bf16_t* bbase(const Unit& u) const { return b_tile(u); }
};
struct MoeFast {
    const bf16_t* A; const bf16_t* Bt; size_t estride; int K, nN, G, c; const LAS int* tl; const int* rowtok; unsigned* dep; int NU, dh, nhi;
    __device__ __forceinline__ bool next(int i, Unit& u) const {
        int L = i * G + c;
        if (NU >= 0) {
            if (i >= dh) { if (c < nhi) return false; L = dh * G + (c - nhi) + (i - dh) * (G - nhi); }
            if (L >= NU) return false;
        }
        int tile = L / nN; u.pn = L % nN; int pm = 0, e = 0;
#pragma unroll 1
        for (; e < NE; ++e) { const int nt = __builtin_amdgcn_readfirstlane(tl[e]); if (tile < nt) break; tile -= nt; pm += nt; }
        if (e == NE) return false;
        u.e = e; u.slot0 = tile * 256; u.pm = pm + tile;
        if (dep) {
            unsigned sp = 0;
            while (__builtin_amdgcn_readfirstlane((int)__hip_atomic_load(dep + u.pm, __ATOMIC_RELAXED, __HIP_MEMORY_SCOPE_AGENT)) < 4) { __builtin_amdgcn_s_sleep(2); if (++sp > (1u << 22)) break; }
        }
        return true;
    }
    __device__ __forceinline__ const bf16_t* abase() const { return A; }
    __device__ __forceinline__ const bf16_t* a_tile(const Unit& u) const { return A + (size_t)(u.pm * 256) * K; }
    __device__ __forceinline__ const bf16_t* b_tile(const Unit& u) const { return Bt + (size_t)u.e * estride + (size_t)(u.pn * 256) * K; }
    __device__ __forceinline__ int tok(const Unit& u, int r) const { const int slot = u.slot0 + r; const int t = rowtok[u.e * ECAP + slot]; return slot < __builtin_amdgcn_readfirstlane(tl[32 + u.e]) ? t : 0; }
    bool gather;
    __device__ __forceinline__ int arow(const Unit& u, int r) const { return gather ? tok(u, r) : u.pm * 256 + r; }
    __device__ __forceinline__ const bf16_t* bbase(const Unit& u) const { return b_tile(u); }
};
constexpr int LDS_SBQ = 131072 + 12288;
constexpr int LDS_TL = 131072 + 4096;
__device__ __forceinline__ const LAS int* moe_table(const int tid, LAS unsigned char* lds, const unsigned* cnt) {
    LAS int* tl = (LAS int*)(lds + LDS_TL);
    if (tid < 32) { const int c = (int)cnt[tid]; tl[tid] = (c + 255) >> 8; tl[32 + tid] = c; }
    __syncthreads();
    return tl;
}

typedef float f32x2z __attribute__((ext_vector_type(2)));
__device__ __forceinline__ f32x4 zero4_asm() { f32x2z lo, hi; asm volatile("v_mov_b64 %0, 0\n\tv_mov_b64 %1, 0" : "=v"(lo), "=v"(hi)); return (f32x4){lo.x, lo.y, hi.x, hi.y}; }
#define ZERO4 zero4_asm()
__device__ __forceinline__ void st16_sc1(void* p, const u32x4& v) { asm volatile("global_store_dwordx4 %0, %1, off sc1\n\ts_nop 1" :: "v"(p), "v"(v) : "memory"); }
struct EpiQKV {
    static constexpr bool SIGNAL = false; __device__ __forceinline__ void signal(const Unit&) const {}
    bf16_t* Q; const float* rstd; const float* rope; float qscale;
    __device__ __forceinline__ void operator()(f32x4 (&acc)[2][2][4][2], const Unit& u, int wr, int wc, int fr, int fq) const {
        const int colt = u.pn * 256, region = colt >> 10, cbase = colt & 1023;
        bf16_t* base = Q + (size_t)region * ((WS_K - WS_Q) / 2);
        const bool dorope = (rope != nullptr) && region < 2;
        const float sc = region == 0 ? qscale : 1.f;
        const int rowb = u.pm * 256 + wr * 64 + fr;
        float rsv[8];
#pragma unroll
        for (int q = 0; q < 8; ++q) rsv[q] = rstd[rowb + (q >> 2) * 128 + (q & 3) * 16];
        f32x4 rp[2][4];
        if (dorope) {
#pragma unroll
            for (int j = 0; j < 4; ++j) rp[0][j] = *(const f32x4*)(rope + rowb * 16 + 4 * j); }
#pragma unroll
        for (int q = 0; q < 8; ++q) { const int ai = q >> 2, m = q & 3;
                const int row = rowb + ai * 128 + m * 16; const float rs = rsv[q];
                if (dorope && q + 1 < 8) { const int rown = rowb + ((q + 1) >> 2) * 128 + ((q + 1) & 3) * 16;
#pragma unroll
                    for (int j = 0; j < 4; ++j) rp[(q + 1) & 1][j] = *(const f32x4*)(rope + rown * 16 + 4 * j); }
                float cs[8], sn[8];
                if (dorope) {
#pragma unroll
                    for (int i = 0; i < 4; ++i) { cs[i] = rp[q & 1][0][i]; cs[4 + i] = rp[q & 1][1][i]; sn[i] = rp[q & 1][2][i]; sn[4 + i] = rp[q & 1][3][i]; } }
#pragma unroll
                for (int bj = 0; bj < 2; ++bj) {
                    float v[8];
#pragma unroll
                    for (int i = 0; i < 4; ++i) { v[i] = acc[ai][bj][m][0][i] * rs; v[4 + i] = acc[ai][bj][m][1][i] * rs; }
                    if (dorope && bj == 0) {
#pragma unroll
                        for (int i = 0; i < 8; ++i) { const float p = __shfl_xor(v[i], 16); const float rot = v[i] * cs[i] + (fq == 0 ? -p : p) * sn[i]; v[i] = fq < 2 ? rot : v[i]; }
                    }
                    u32x4 w; w.x = cvtpk(v[0] * sc, v[1] * sc); w.y = cvtpk(v[2] * sc, v[3] * sc); w.z = cvtpk(v[4] * sc, v[5] * sc); w.w = cvtpk(v[6] * sc, v[7] * sc);
                    *(u32x4*)(base + (size_t)row * DM + cbase + wc * 64 + bj * 32 + 8 * fq) = w;
                }
                acc[ai][0][m][0] = ZERO4; acc[ai][0][m][1] = ZERO4; acc[ai][1][m][0] = ZERO4; acc[ai][1][m][1] = ZERO4;
            }
    }
};
struct EpiRes {
    static constexpr bool SIGNAL = false; __device__ __forceinline__ void signal(const Unit&) const {}
    static constexpr int NST = 16;
    bf16_t* hb;
    __device__ __forceinline__ void operator()(f32x4 (&acc)[2][2][4][2], const Unit& u, int wr, int wc, int fr, int fq) const {
        bf16_t* p0 = hb + (size_t)(u.pm * 256 + wr * 64 + fr) * DM + u.pn * 256 + wc * 64 + 8 * fq;
        u32x4 r[2][4][2];
#pragma unroll
        for (int ai = 0; ai < 2; ++ai)
#pragma unroll
            for (int m = 0; m < 4; ++m)
#pragma unroll
                for (int bj = 0; bj < 2; ++bj) r[ai][m][bj] = *(const u32x4*)(p0 + (size_t)(ai * 128 + m * 16) * DM + bj * 32);
#pragma unroll
        for (int ai = 0; ai < 2; ++ai)
#pragma unroll
            for (int m = 0; m < 4; ++m)
#pragma unroll
                for (int bj = 0; bj < 2; ++bj) { const u32x4 rr = r[ai][m][bj]; const f32x4 a0 = acc[ai][bj][m][0], a1 = acc[ai][bj][m][1];
                    u32x4 w; w.x = cvtpk(bflo(rr.x) + a0[0], bfhi(rr.x) + a0[1]); w.y = cvtpk(bflo(rr.y) + a0[2], bfhi(rr.y) + a0[3]); w.z = cvtpk(bflo(rr.z) + a1[0], bfhi(rr.z) + a1[1]); w.w = cvtpk(bflo(rr.w) + a1[2], bfhi(rr.w) + a1[3]);
                    *(u32x4*)(p0 + (size_t)(ai * 128 + m * 16) * DM + bj * 32) = w; acc[ai][bj][m][0] = ZERO4; acc[ai][bj][m][1] = ZERO4; }
    }
};
struct EpiGateUp {
    bf16_t* hid; const float* rowrs; const LAS int* tl; unsigned* done;
    static constexpr bool SIGNAL = FUSE_MOE != 0;
    __device__ __forceinline__ void signal(const Unit& u) const { (void)__hip_atomic_fetch_add(done + u.pm, 1u, __ATOMIC_RELAXED, __HIP_MEMORY_SCOPE_AGENT); }
    __device__ __forceinline__ void operator()(f32x4 (&acc)[2][2][4][2], const Unit& u, int wr, int wc, int fr, int fq) const {
        const int nrow = __builtin_amdgcn_readfirstlane(tl[32 + u.e]);
        float rsv[8];
#pragma unroll
        for (int q = 0; q < 8; ++q) rsv[q] = rowrs[u.e * ECAP + u.slot0 + (q >> 2) * 128 + wr * 64 + (q & 3) * 16 + fr];
#pragma unroll
        for (int ai = 0; ai < 2; ++ai)
#pragma unroll
            for (int m = 0; m < 4; ++m) {
                const int r = ai * 128 + wr * 64 + m * 16 + fr; const int slot = u.slot0 + r; const float rs = slot < nrow ? rsv[ai * 4 + m] : 0.f;
                float h[8];
#pragma unroll
                for (int i = 0; i < 8; ++i) { const float g = acc[ai][0][m][i >> 2][i & 3] * rs, up = acc[ai][1][m][i >> 2][i & 3] * rs; h[i] = g * __builtin_amdgcn_rcpf(1.f + __builtin_amdgcn_exp2f(-g * LOG2E)) * up; }
                u32x4 w; w.x = cvtpk(h[0], h[1]); w.y = cvtpk(h[2], h[3]); w.z = cvtpk(h[4], h[5]); w.w = cvtpk(h[6], h[7]);
                if (SIGNAL) st16_sc1(hid + (size_t)(u.pm * 256 + r) * FF + u.pn * 128 + wc * 32 + 8 * fq, w); else *(u32x4*)(hid + (size_t)(u.pm * 256 + r) * FF + u.pn * 128 + wc * 32 + 8 * fq) = w;
                acc[ai][0][m][0] = ZERO4; acc[ai][0][m][1] = ZERO4; acc[ai][1][m][0] = ZERO4; acc[ai][1][m][1] = ZERO4;
            }
    }
};
struct EpiDown {
    static constexpr bool SIGNAL = false; __device__ __forceinline__ void signal(const Unit&) const {}
    bf16_t* Y; const float* rowgate; const LAS int* tl;
    __device__ __forceinline__ void operator()(f32x4 (&acc)[2][2][4][2], const Unit& u, int wr, int wc, int fr, int fq) const {
        const int nrow = __builtin_amdgcn_readfirstlane(tl[32 + u.e]);
        float gtv[8];
#pragma unroll
        for (int q = 0; q < 8; ++q) gtv[q] = rowgate[u.e * ECAP + u.slot0 + (q >> 2) * 128 + wr * 64 + (q & 3) * 16 + fr];
#pragma unroll
        for (int ai = 0; ai < 2; ++ai)
#pragma unroll
            for (int m = 0; m < 4; ++m) {
                const int r = ai * 128 + wr * 64 + m * 16 + fr; const int slot = u.slot0 + r; const float gt = slot < nrow ? gtv[ai * 4 + m] : 0.f;
#pragma unroll
                for (int bj = 0; bj < 2; ++bj) { const f32x4 a0 = acc[ai][bj][m][0] * gt, a1 = acc[ai][bj][m][1] * gt;
                    u32x4 w; w.x = cvtpk(a0[0], a0[1]); w.y = cvtpk(a0[2], a0[3]); w.z = cvtpk(a1[0], a1[1]); w.w = cvtpk(a1[2], a1[3]);
                    *(u32x4*)(Y + (size_t)(u.pm * 256 + r) * DM + u.pn * 256 + wc * 64 + bj * 32 + 8 * fq) = w; acc[ai][bj][m][0] = ZERO4; acc[ai][bj][m][1] = ZERO4; }
            }
    }
};

__device__ __forceinline__ void qk_tile(f32x16& p0, f32x16& p1, const bf16_t* Kt, const bf16x8* qr, int r32, int hi) {
    p0 = (f32x16){}; p1 = (f32x16){};
    const bf16_t* kp = Kt + (size_t)r32 * DM + hi * 8; asm volatile("" : "+v"(kp));
#pragma unroll
    for (int d0 = 0; d0 < 4; ++d0) {
        const bf16x8 b0 = *(const bf16x8*)(kp + d0 * 16), b1 = *(const bf16x8*)(kp + 32 * DM + d0 * 16);
        p0 = MFMA32(b0, qr[d0], p0); p1 = MFMA32(b1, qr[d0], p1);
    }
}
typedef short v4i16_t __attribute__((ext_vector_type(4)));
typedef short s16x4 __attribute__((ext_vector_type(4)));
__device__ __forceinline__ s16x4 vtr(LAS const unsigned char* p) { return __builtin_bit_cast(s16x4, __builtin_amdgcn_ds_read_tr16_b64_v4i16((LAS v4i16_t*)p)); }
template <int ND>
__device__ __forceinline__ void pv_tile(f32x16* o, const f32x16& p0, const f32x16& p1, const bf16_t* Vt, LAS unsigned char* vs, int lane) {
    const int hi = lane >> 5;
    asm volatile("" ::: "memory");
#pragma unroll
    for (int i0 = 0; i0 < ND * 4; i0 += 4) {
        u32x4 t[4];
        const bf16_t* vp = Vt + (size_t)(lane / (ND * 4)) * DM + (lane % (ND * 4)) * 8; asm volatile("" : "+v"(vp));
#pragma unroll
        for (int i = 0; i < 4; ++i) t[i] = *(const u32x4*)(vp + (size_t)((i0 + i) * (64 / (ND * 4))) * DM);
        asm volatile("" : "+v"(t[0]), "+v"(t[1]), "+v"(t[2]), "+v"(t[3]));
#pragma unroll
        for (int i = 0; i < 4; ++i) { const int c = (i0 + i) * 64 + lane, row = c / (ND * 4), ch = c % (ND * 4); *(LAS u32x4*)(vs + (ch >> 2) * 4096 + row * 64 + (ch & 3) * 16) = t[i]; }
    }
    asm volatile("s_waitcnt lgkmcnt(0)" ::: "memory");
    u32x4 pw[4];
    pw[0] = (u32x4){cvtpk(p0[0], p0[1]), cvtpk(p0[2], p0[3]), cvtpk(p0[4], p0[5]), cvtpk(p0[6], p0[7])};
    pw[1] = (u32x4){cvtpk(p0[8], p0[9]), cvtpk(p0[10], p0[11]), cvtpk(p0[12], p0[13]), cvtpk(p0[14], p0[15])};
    pw[2] = (u32x4){cvtpk(p1[0], p1[1]), cvtpk(p1[2], p1[3]), cvtpk(p1[4], p1[5]), cvtpk(p1[6], p1[7])};
    pw[3] = (u32x4){cvtpk(p1[8], p1[9]), cvtpk(p1[10], p1[11]), cvtpk(p1[12], p1[13]), cvtpk(p1[14], p1[15])};
    LAS const unsigned char* vb = vs + ((lane >> 4) & 1) * 32 + (lane & 3) * 8 + (4 * hi + ((lane & 15) >> 2)) * 64;
#pragma unroll
    for (int d0 = 0; d0 < ND; ++d0) {
#pragma unroll
        for (int ks = 0; ks < 4; ++ks) {
            const s16x4 lo = vtr(vb + d0 * 4096 + ks * 1024), hh = vtr(vb + d0 * 4096 + ks * 1024 + 512);
            const bf16x8 vf = (bf16x8){lo[0], lo[1], lo[2], lo[3], hh[0], hh[1], hh[2], hh[3]};
            o[d0] = MFMA32(__builtin_bit_cast(bf16x8, pw[ks]), vf, o[d0]);
        }
    }
    asm volatile("s_waitcnt lgkmcnt(0)" ::: "memory");
}

__device__ __forceinline__ void diff_map(Frame& F, f32x16* o, const bf16_t* Q, const bf16_t* K, const bf16_t* V, size_t rb, int q0, int h, int mp) {
    const int lane = F.lane, r32 = lane & 31, hi = lane >> 5;
    LAS float* wsf = (LAS float*)(F.lds + 131072 + F.wave * 512);
    bf16x8 qr[4];
#pragma unroll
    for (int d0 = 0; d0 < 4; ++d0) qr[d0] = *(const bf16x8*)(Q + (rb + q0 + r32) * DM + h * 128 + mp * 64 + d0 * 16 + hi * 8);
    o[0] = (f32x16){}; o[1] = (f32x16){}; o[2] = (f32x16){}; o[3] = (f32x16){};
    float mrun = -1e30f, l = 0.f;
    const int nt = (q0 >> 6) + 1;
#pragma unroll 1
    for (int t = 0; t < nt; ++t) {
        const int key0 = t * 64; f32x16 p0, p1;
        qk_tile(p0, p1, K + (rb + key0) * DM + h * 128 + mp * 64, qr, r32, hi);
        if (t == nt - 1) { const int q = q0 + r32;
#pragma unroll
            for (int r = 0; r < 16; ++r) { const int kv = key0 + crow(r, hi); if (kv > q) p0[r] = -1e30f; if (kv + 32 > q) p1[r] = -1e30f; } }
        float mx = p0[0];
#pragma unroll
        for (int r = 1; r < 16; ++r) mx = fmaxf(mx, p0[r]);
#pragma unroll
        for (int r = 0; r < 16; ++r) mx = fmaxf(mx, p1[r]);
        mx = fmaxf(mx, __shfl_xor(mx, 32));
        const float mnew = fmaxf(mrun, mx), f = __builtin_amdgcn_exp2f(mrun - mnew); mrun = mnew;
        float rs = 0.f;
#pragma unroll
        for (int r = 0; r < 16; ++r) { p0[r] = __builtin_amdgcn_exp2f(p0[r] - mnew); p1[r] = __builtin_amdgcn_exp2f(p1[r] - mnew); rs += p0[r] + p1[r]; }
        l = l * f + rs;
        if (hi == 0) wsf[r32] = f;
        asm volatile("s_waitcnt lgkmcnt(0)" ::: "memory");
#pragma unroll
        for (int r = 0; r < 16; ++r) { const float fr_ = wsf[crow(r, hi)];
#pragma unroll
            for (int d0 = 0; d0 < 4; ++d0) o[d0][r] *= fr_; }
        asm volatile("s_waitcnt lgkmcnt(0)" ::: "memory");
        pv_tile<4>(o, p0, p1, V + (rb + key0) * DM + h * 128, F.lds + F.wave * 16384, lane);
    }
    l += __shfl_xor(l, 32);
    if (hi == 0) wsf[32 + r32] = 1.f / l;
    asm volatile("s_waitcnt lgkmcnt(0)" ::: "memory");
#pragma unroll
    for (int r = 0; r < 16; ++r) { const float rr = wsf[32 + crow(r, hi)];
#pragma unroll
        for (int d0 = 0; d0 < 4; ++d0) o[d0][r] *= rr; }
    asm volatile("s_waitcnt lgkmcnt(0)" ::: "memory");
}
__device__ __forceinline__ void attn_diff_simple(Frame& F, const Args& A) {
    const int lane = F.lane, r32 = lane & 31, hi = lane >> 5;
    const bf16_t* Q = (const bf16_t*)(F.ws + WS_Q); const bf16_t* K = (const bf16_t*)(F.ws + WS_K); const bf16_t* V = (const bf16_t*)(F.ws + WS_V); bf16_t* AO = (bf16_t*)(F.ws + WS_AO);
    LAS float* stg = (LAS float*)(F.lds + F.wave * 16384);
    const float d1 = A.a_lq1[lane] * A.a_lk1[lane], d2 = A.a_lq2[lane] * A.a_lk2[lane];
    const float lam = __expf(wave_sum(d1)) - __expf(wave_sum(d2)) + 0.2f;
    const f32x4 sl = *(const f32x4*)(A.a_subln + 4 * r32) * 0.8f;
    const int gw = F.vcu * NWAVES + F.wave, NGW = F.G * NWAVES;
#pragma unroll 1
    for (int it = gw; it < BATCH * 8 * 128; it += NGW) {
        const int bh = it & 63, b = bh >> 3, h = bh & 7; const int qi = it >> 6, i4 = qi >> 5, j = qi & 31;
        const int qb = (i4 == 0) ? 127 - j : (i4 == 1) ? j : (i4 == 2) ? 95 - j : 32 + j;
        const int q0 = qb * 32; const size_t rb = (size_t)b * SEQ;
        f32x16 o[4];
        diff_map(F, o, Q, K, V, rb, q0, h, 0);
#pragma unroll
        for (int r = 0; r < 16; ++r)
#pragma unroll
            for (int d0 = 0; d0 < 4; ++d0) stg[crow(r, hi) * 128 + d0 * 32 + r32] = o[d0][r];
        asm volatile("s_waitcnt lgkmcnt(0)" ::: "memory");
        float* park = A.out + (rb + q0 + hi) * DM + h * 128 + 4 * r32;
#pragma unroll 4
        for (int i = 0; i < 16; ++i) *(f32x4*)(park + (size_t)(2 * i) * DM) = *(const LAS f32x4*)(stg + (2 * i + hi) * 128 + 4 * r32);
        asm volatile("s_waitcnt lgkmcnt(0)" ::: "memory");
        diff_map(F, o, Q, K, V, rb, q0, h, 1);
#pragma unroll
        for (int r = 0; r < 16; ++r)
#pragma unroll
            for (int d0 = 0; d0 < 4; ++d0) stg[crow(r, hi) * 128 + d0 * 32 + r32] = o[d0][r];
        asm volatile("s_waitcnt lgkmcnt(0)" ::: "memory");
        bf16_t* ao = AO + (rb + q0 + hi) * DM + h * 128 + 4 * r32;
#pragma unroll 4
        for (int i = 0; i < 16; ++i) {
            const f32x4 o1 = *(const LAS f32x4*)(stg + (2 * i + hi) * 128 + 4 * r32), o0 = *(const f32x4*)(park + (size_t)(2 * i) * DM);
            const f32x4 d = o0 - lam * o1;
            float ss = (d[0] * d[0] + d[1] * d[1]) + (d[2] * d[2] + d[3] * d[3]);
#pragma unroll
            for (int o_ = 1; o_ < 32; o_ <<= 1) ss += __shfl_xor(ss, o_);
            const float rn = __builtin_amdgcn_rsqf(ss * (1.f / 128.f) + EPS);
            u32x2 w; w.x = cvtpk(d[0] * rn * sl[0], d[1] * rn * sl[1]); w.y = cvtpk(d[2] * rn * sl[2], d[3] * rn * sl[3]);
            *(u32x2*)(ao + (size_t)(2 * i) * DM) = w;
        }
        asm volatile("s_waitcnt lgkmcnt(0)" ::: "memory");
    }
}

__device__ __forceinline__ void sb_load_half(u32x4 (&kr)[4], const bf16_t* Kt, const bf16_t* Vt, LAS unsigned char* vbuf, int lane) {
    const int r32 = lane & 31, hi = lane >> 5;
    unsigned ko = (unsigned)(r32 * DM + hi * 8) * 2u; asm volatile("" : "+v"(ko));
    const GAS char* kp = (const GAS char*)Kt + ko;
#pragma unroll
    for (int d0 = 0; d0 < 4; ++d0) kr[d0] = *(const GAS u32x4*)(kp + d0 * 32);
    unsigned vo = (unsigned)((lane >> 2) * DM + (lane & 3) * 8) * 2u; asm volatile("" : "+v"(vo));
    const GAS char* vp = (const GAS char*)Vt + vo;
#pragma unroll
    for (int db = 0; db < 2; ++db)
#pragma unroll
        for (int i = 0; i < 2; ++i) __builtin_amdgcn_global_load_lds((const GAS unsigned*)(vp + (size_t)(16 * i) * DM * 2 + db * 64), (LAS unsigned*)(vbuf + db * 2048 + i * 1024), 16, 0, 0);
}
__device__ __forceinline__ void attn_sb_simple(Frame& F, const Args& A) {
    const int lane = F.lane, r32 = lane & 31, hi = lane >> 5;
    const bf16_t* Q = (const bf16_t*)(F.ws + WS_Q); const bf16_t* K = (const bf16_t*)(F.ws + WS_K); const bf16_t* V = (const bf16_t*)(F.ws + WS_V); bf16_t* AO = (bf16_t*)(F.ws + WS_AO);
    LAS unsigned char* vs = F.lds + F.wave * 16384;
    const int gw = F.vcu * NWAVES + F.wave, NGW = F.G * NWAVES;
    LAS unsigned* tq = (LAS unsigned*)(F.lds + LDS_SBQ);
    if (F.tid == 0) *tq = NWAVES;
    __syncthreads();
    constexpr int SB_UNITS = BATCH * 16 * 128;
    auto draw = [&]() -> int {
        for (;;) { unsigned tk = 0; if (lane == 0) tk = __hip_atomic_fetch_add(tq, 1u, __ATOMIC_RELAXED, __HIP_MEMORY_SCOPE_WORKGROUP);
            const int k = (int)__builtin_amdgcn_readfirstlane(tk); if ((k / NWAVES) * NGW >= SB_UNITS) return -1;
            const int it_ = F.vcu * NWAVES + (k & (NWAVES - 1)) + (k / NWAVES) * NGW; if (it_ < SB_UNITS) return it_; } };
    u32x4 kr[4]; bf16x8 qr[4];
    auto prefetch = [&](int it_) { const int bh_ = it_ & 127, b_ = bh_ >> 4, h_ = bh_ & 15, qb_ = 127 - (it_ >> 7); const size_t rb_ = (size_t)b_ * SEQ;
        sb_load_half(kr, K + (rb_ + qb_ * 32) * DM + h_ * 64, V + (rb_ + qb_ * 32) * DM + h_ * 64, vs + (qb_ & 1) * 4096, lane);
#pragma unroll
        for (int d0 = 0; d0 < 4; ++d0) qr[d0] = *(const bf16x8*)(Q + (rb_ + qb_ * 32 + r32) * DM + h_ * 64 + d0 * 16 + hi * 8); };
    int it = F.vcu * NWAVES + F.wave; if (it >= SB_UNITS) it = draw();
    if (it >= 0) prefetch(it);
#pragma unroll 1
    while (it >= 0) {
        const int itn = draw();
        {
        const int bh = it & 127, b = bh >> 4, h = bh & 15; const int qb = 127 - (it >> 7);
        const int q0 = qb * 32; const size_t rb = (size_t)b * SEQ;
        int u = qb;
        f32x16 o[2]; o[0] = (f32x16){}; o[1] = (f32x16){};
        float R = 1.f;
#pragma unroll 1
        for (; u >= 0; --u) {
            f32x16 p = (f32x16){};
#pragma unroll
            for (int d0 = 0; d0 < 4; ++d0) p = MFMA32(__builtin_bit_cast(bf16x8, kr[d0]), qr[d0], p);
            if (u > 0) sb_load_half(kr, K + (rb + (u - 1) * 32) * DM + h * 64, V + (rb + (u - 1) * 32) * DM + h * 64, vs + ((u - 1) & 1) * 4096, lane);
            f32x16 bt, m;
#pragma unroll
            for (int r = 0; r < 16; ++r) { float t; asm("v_max_f32_e32 %0, 0xc2f00000, %1" : "=v"(t) : "v"(p[r]));
                const float e = __builtin_amdgcn_exp2f(-t); const float bb = __builtin_amdgcn_rcpf(1.f + e); bt[r] = bb; m[r] = e * bb; }
            if (u == qb) {
#pragma unroll
                for (int r = 0; r < 16; ++r) if (!(crow(r, hi) < r32)) { bt[r] = 0.f; m[r] = 1.f; }
                asm volatile("" : "+v"(bt), "+v"(m));
            }
            float gp[4], og[4];
#pragma unroll
            for (int i = 0; i < 4; ++i) gp[i] = (m[4 * i] * m[4 * i + 1]) * (m[4 * i + 2] * m[4 * i + 3]);
#pragma unroll
            for (int i = 0; i < 4; ++i) og[i] = __shfl_xor(gp[i], 32);
            float tb[4]; float run = 1.f;
#pragma unroll
            for (int i = 3; i >= 0; --i) { tb[i] = R * run * (hi == 0 ? og[i] : 1.f); run *= gp[i] * og[i]; }
#pragma unroll
            for (int i = 0; i < 4; ++i) { const float s3 = tb[i], s2 = s3 * m[4 * i + 3], s1 = s2 * m[4 * i + 2], s0 = s1 * m[4 * i + 1];
                bt[4 * i + 3] *= s3; bt[4 * i + 2] *= s2; bt[4 * i + 1] *= s1; bt[4 * i] *= s0; }
            R *= run;
            { u32x4 pw[2];
              pw[0] = (u32x4){cvtpk(bt[0], bt[1]), cvtpk(bt[2], bt[3]), cvtpk(bt[4], bt[5]), cvtpk(bt[6], bt[7])};
              pw[1] = (u32x4){cvtpk(bt[8], bt[9]), cvtpk(bt[10], bt[11]), cvtpk(bt[12], bt[13]), cvtpk(bt[14], bt[15])};
              LAS const unsigned char* vb = vs + (u & 1) * 4096 + ((lane >> 4) & 1) * 32 + (lane & 3) * 8 + (4 * hi + ((lane & 15) >> 2)) * 64;
#pragma unroll
              for (int d0 = 0; d0 < 2; ++d0)
#pragma unroll
                  for (int ks = 0; ks < 2; ++ks) { const s16x4 lo = vtr(vb + d0 * 2048 + ks * 1024), hh = vtr(vb + d0 * 2048 + ks * 1024 + 512);
                      const bf16x8 vf = (bf16x8){lo[0], lo[1], lo[2], lo[3], hh[0], hh[1], hh[2], hh[3]};
                      o[d0] = MFMA32(__builtin_bit_cast(bf16x8, pw[ks]), vf, o[d0]); }
              asm volatile("s_waitcnt lgkmcnt(0)" ::: "memory"); }
            if (__all(R == 0.f)) break;
        }
        if (itn >= 0) prefetch(itn);
        { LAS float* stg = (LAS float*)(vs + 8192);
#pragma unroll
          for (int r = 0; r < 16; ++r)
#pragma unroll
              for (int d0 = 0; d0 < 2; ++d0) stg[crow(r, hi) * 64 + d0 * 32 + r32] = o[d0][r];
          asm volatile("s_waitcnt lgkmcnt(0)" ::: "memory");
          bf16_t* ao = AO + (rb + q0 + (lane >> 4)) * DM + h * 64 + 4 * (lane & 15);
#pragma unroll 4
          for (int i = 0; i < 8; ++i) { const f32x4 v = *(const LAS f32x4*)(stg + (4 * i + (lane >> 4)) * 64 + 4 * (lane & 15)); u32x2 w; w.x = cvtpk(v[0], v[1]); w.y = cvtpk(v[2], v[3]); *(u32x2*)(ao + (size_t)(4 * i) * DM) = w; }
          asm volatile("s_waitcnt lgkmcnt(0)" ::: "memory"); }
        }
        it = itn;
    }
    __syncthreads();
}

#include <hip/hip_bf16.h>
#include <cmath>
namespace attn_body {
using bf16=__hip_bfloat16;
using bf16x8=__attribute__((ext_vector_type(8)))short;
using s16x4=__attribute__((ext_vector_type(4)))short;
using f32x16=__attribute__((ext_vector_type(16)))float;
using u32x4=__attribute__((ext_vector_type(4)))unsigned;
constexpr int BATCH=8,NHEAD=16,SEQ=4096,D=64,DM=NHEAD*D;
constexpr int NW=8,QBLK=32,QB=QBLK*NW,KVBLK=64,NQB=SEQ/QB;
constexpr int ATTN_PITCH=DM, ATTN_UNIT_ROWS=QB;
__device__ __forceinline__ int crow(int r,int hi){return (r&3)+8*(r>>2)+4*hi;}
#define SBAR() __builtin_amdgcn_sched_barrier(0)
__device__ __forceinline__ void cmask(f32x16&p0,f32x16&p1,int jb,int qrel,int hi){
  const float NEG=-INFINITY; int kb=64*jb+4*hi;
  #pragma unroll
  for(int r=0;r<16;++r){int kv=kb+(r&3)+8*(r>>2); if(kv>qrel)p0[r]=NEG; if(kv+32>qrel)p1[r]=NEG;}
}

constexpr int NSLOT=3, SLOTB=8192;
constexpr int LDS_K=0, LDS_V=NSLOT*SLOTB, LDS_WS=2*NSLOT*SLOTB, LDS_OST=LDS_WS+NW*64*4, LDS_BYTES=LDS_OST+NW*4096;
constexpr float C2=0.125f*1.4426950408889634f;
__device__ __forceinline__ void glds16(const void*sbase,unsigned voff,unsigned lds_dst){unsigned keep;
  asm volatile("s_nop 4\n\ts_mov_b32 %0, m0\n\ts_mov_b32 m0, %3\n\ts_nop 0\n\tglobal_load_lds_dwordx4 %1, %2\n\ts_mov_b32 m0, %0":"=&s"(keep):"v"(voff),"s"(sbase),"s"(lds_dst):"memory");}
__device__ __forceinline__ float max3f(float a,float b,float c){float r;asm("v_max3_f32 %0, %1, %2, %3":"=v"(r):"v"(a),"v"(b),"v"(c));return r;}
__device__ __forceinline__ float max2f(float a,float b){float r;asm("v_max_f32_e32 %0, %1, %2":"=v"(r):"v"(a),"v"(b));return r;}
__device__ __forceinline__ float fadd_s(float a,float b){float r;asm("v_add_f32_e32 %0, %1, %2":"=v"(r):"v"(a),"v"(b));return r;}
__device__ __forceinline__ float fsub_s(float a,float b){float r;asm("v_sub_f32_e32 %0, %1, %2":"=v"(r):"v"(a),"v"(b));return r;}
typedef float f32x2_t __attribute__((ext_vector_type(2))); typedef __bf16 bf16x2_t __attribute__((ext_vector_type(2)));
__device__ __forceinline__ unsigned cvtpk_s(float lo,float hi){f32x2_t v={lo,hi};bf16x2_t b=__builtin_convertvector(v,bf16x2_t);return __builtin_bit_cast(unsigned,b);}
#define WAIT_BAR(N) asm volatile("s_waitcnt vmcnt(" #N ") lgkmcnt(0)\n\ts_barrier":::"memory")

__device__ __forceinline__ void qkt(f32x16&p0,f32x16&p1,const char*Kslot,const bf16x8*qr,const f32x16&negm,int r32,int hi){
  const char*kb=Kslot+hi*1024+r32*16;
  #pragma unroll
  for(int d0=0;d0<4;++d0){
    const bf16x8 b0=*reinterpret_cast<const bf16x8*>(kb+d0*2048);
    const bf16x8 b1=*reinterpret_cast<const bf16x8*>(kb+d0*2048+512);
    if(d0==0){p0=__builtin_amdgcn_mfma_f32_32x32x16_bf16(b0,qr[0],negm,0,0,0);p1=__builtin_amdgcn_mfma_f32_32x32x16_bf16(b1,qr[0],negm,0,0,0);}
    else{p0=__builtin_amdgcn_mfma_f32_32x32x16_bf16(b0,qr[d0],p0,0,0,0);p1=__builtin_amdgcn_mfma_f32_32x32x16_bf16(b1,qr[d0],p1,0,0,0);}}
}
typedef __attribute__((address_space(3))) const char* lds_cptr;
typedef short v4i16_t __attribute__((ext_vector_type(4)));
__device__ __forceinline__ void kload8(bf16x8*kf,lds_cptr kp){
  kf[0]=*(const __attribute__((address_space(3))) bf16x8*)(kp);      kf[1]=*(const __attribute__((address_space(3))) bf16x8*)(kp+512);
  kf[2]=*(const __attribute__((address_space(3))) bf16x8*)(kp+2048); kf[3]=*(const __attribute__((address_space(3))) bf16x8*)(kp+2560);
  kf[4]=*(const __attribute__((address_space(3))) bf16x8*)(kp+4096); kf[5]=*(const __attribute__((address_space(3))) bf16x8*)(kp+4608);
  kf[6]=*(const __attribute__((address_space(3))) bf16x8*)(kp+6144); kf[7]=*(const __attribute__((address_space(3))) bf16x8*)(kp+6656);
}
__device__ __forceinline__ void kload2(bf16x8*kf,lds_cptr kp,int j){ kf[2*j]=*(const __attribute__((address_space(3))) bf16x8*)(kp+j*2048); kf[2*j+1]=*(const __attribute__((address_space(3))) bf16x8*)(kp+j*2048+512); }
__device__ __forceinline__ s16x4 vtr(lds_cptr p){ return __builtin_bit_cast(s16x4,__builtin_amdgcn_ds_read_tr16_b64_v4i16((__attribute__((address_space(3))) v4i16_t*)p)); }
__device__ __forceinline__ float rowmax(const f32x16&p0,const f32x16&p1){
  float a=max3f(p0[0],p0[1],p1[0]),b=max3f(p0[2],p0[3],p1[1]);a=max3f(a,p1[2],p1[3]);
  #pragma unroll
  for(int r=4;r<16;r+=4){a=max3f(a,p0[r],p0[r+1]);b=max3f(b,p0[r+2],p0[r+3]);a=max3f(a,p1[r],p1[r+1]);b=max3f(b,p1[r+2],p1[r+3]);}
  const float m=max2f(a,b);
  auto rr=__builtin_amdgcn_permlane32_swap(__float_as_uint(m),__float_as_uint(m),false,false);
  return max2f(__uint_as_float(rr[0]),__uint_as_float(rr[1]));
}
__device__ __forceinline__ void pv(f32x16*o,int vb,bf16x8 pa0,bf16x8 pa1,bf16x8 pa2,bf16x8 pa3){
  #pragma unroll
  for(int d0=0;d0<2;++d0){s16x4 lo[4],hi[4];
    #pragma unroll
    for(int ks=0;ks<4;++ks){
      asm volatile("ds_read_b64_tr_b16 %0,%1 offset:%c2":"=&v"(lo[ks]):"v"(vb),"i"(d0*4096+ks*1024):"memory");
      asm volatile("ds_read_b64_tr_b16 %0,%1 offset:%c2":"=&v"(hi[ks]):"v"(vb),"i"(d0*4096+ks*1024+512):"memory");}
    asm volatile("s_waitcnt lgkmcnt(0)":::"memory");SBAR();
    #define PK(k) (bf16x8){lo[k][0],lo[k][1],lo[k][2],lo[k][3],hi[k][0],hi[k][1],hi[k][2],hi[k][3]}
    o[d0]=__builtin_amdgcn_mfma_f32_32x32x16_bf16(pa0,PK(0),o[d0],0,0,0);
    o[d0]=__builtin_amdgcn_mfma_f32_32x32x16_bf16(pa1,PK(1),o[d0],0,0,0);
    o[d0]=__builtin_amdgcn_mfma_f32_32x32x16_bf16(pa2,PK(2),o[d0],0,0,0);
    o[d0]=__builtin_amdgcn_mfma_f32_32x32x16_bf16(pa3,PK(3),o[d0],0,0,0);
    #undef PK
  }
}

#ifndef ATTN_STORE16
#define ATTN_STORE16(p,v) (*(u32x4*)(p)=(v))
#endif
template<int THRL> __device__ __forceinline__ void attn_unit(int tid,int b,int h,int hv,int qb,const bf16*Q,const bf16*__restrict__ K,const bf16*__restrict__ V,bf16*O,char*shm){
  const int lane=tid&63,r32=lane&31,hi=lane>>5; const int wid=__builtin_amdgcn_readfirstlane(tid>>6);
  const long rowbase=(long)b*SEQ; const int q0=qb*QB;
  const bf16*Qw=Q+(rowbase+q0+wid*QBLK)*DM+h*D;
  const bf16*Kh=K+rowbase*DM+h*D,*Vh=V+rowbase*DM+hv*D;
  const unsigned lds0=(unsigned)(uintptr_t)shm;
  float*wsf=(float*)(shm+LDS_WS)+wid*64;
  const unsigned ksrc=(unsigned)(lane*DM+wid*8)*2u;
  const unsigned vsrc=(unsigned)((16*(wid&3)+(lane>>2))*DM+(wid>>2)*32+(lane&3)*8)*2u;
  const unsigned kdst=lds0+LDS_K+wid*1024, vdst=lds0+LDS_V+wid*1024;
  #define DMA_K(t,slot) glds16(Kh+(long)(t)*KVBLK*DM,ksrc,(unsigned)__builtin_amdgcn_readfirstlane(kdst+(slot)))
  #define DMA_V(t,slot) glds16(Vh+(long)(t)*KVBLK*DM,vsrc,(unsigned)__builtin_amdgcn_readfirstlane(vdst+(slot)))
  const int vb0=(int)(lds0+LDS_V)+((lane>>4)&1)*32+(lane&3)*8+(4*hi+((lane&15)>>2))*64;
  const char*Kbase=shm+LDS_K; bf16x8 kf[8];
  const lds_cptr shm3=(lds_cptr)shm; const lds_cptr kp0=shm3+LDS_K+hi*1024+r32*16; const lds_cptr vp0=shm3+LDS_V+((lane>>4)&1)*32+(lane&3)*8+(4*hi+((lane&15)>>2))*64;
  const int NT=(q0+QB)/KVBLK;
  DMA_K(0,0);DMA_V(0,0);DMA_K(1,SLOTB);
  bf16x8 qr[4];
  #pragma unroll
  for(int d0=0;d0<4;++d0)qr[d0]=*reinterpret_cast<const bf16x8*>(&Qw[(long)r32*DM+d0*16+hi*8]);
  float mhat=0.f,l_reg=0.f;f32x16 o[2];o[0]=f32x16{};o[1]=f32x16{};float z_=0.f;asm volatile("":"+v"(z_)); f32x16 negm; _Pragma("unroll") for(int r=0;r<16;++r)negm[r]=z_; asm volatile("":"+v"(negm));
  const int qrel=wid*QBLK+r32;
  #define CMASK(P0,P1,t) do{int jb_=(t)-(NT-4); if(jb_>=0)cmask(P0,P1,jb_,qrel,hi);}while(0)
  bool resc=false;
  #define START(P0,P1) do{ const float rm=rowmax(P0,P1); resc=false; \
    { const float dl=rm; mhat=fadd_s(mhat,dl); \
      _Pragma("unroll") for(int r=0;r<16;++r){P0[r]=fsub_s(P0[r],dl);P1[r]=fsub_s(P1[r],dl);} \
      _Pragma("unroll") for(int r=0;r<16;++r)negm[r]=-mhat; asm volatile("":"+v"(negm)); } \
    _Pragma("unroll") for(int r=0;r<16;++r)P0[r]=__builtin_amdgcn_exp2f(P0[r]); }while(0)
  #define RESC() do{ if(resc){ asm volatile("s_waitcnt lgkmcnt(0)":::"memory"); \
      _Pragma("unroll") for(int d_=0;d_<2;++d_) _Pragma("unroll") for(int r=0;r<16;++r)o[d_][r]*=wsf[crow(r,hi)]; } }while(0)
  f32x16 pA0,pA1,pB0,pB1;
  int sl_prev=0,sl_cur=0,sl_next=SLOTB;
  #define ROT() do{sl_prev=sl_cur;sl_cur=sl_next;sl_next=(sl_next==(NSLOT-1)*SLOTB)?0:sl_next+SLOTB;}while(0)
  DMA_K(2,2*SLOTB);
  WAIT_BAR(3);
  qkt(pA0,pA1,Kbase,qr,negm,r32,hi);asm volatile("s_nop 15\n\ts_nop 7":"+v"(pA0),"+v"(pA1));CMASK(pA0,pA1,0);
  START(pA0,pA1);
  _Pragma("unroll") for(int r=0;r<16;++r)pA1[r]=__builtin_amdgcn_exp2f(pA1[r]);
  WAIT_BAR(0);
  DMA_K(3,0);DMA_V(1,SLOTB);
  ROT();
  kload8(kf,kp0+sl_cur);
  WAIT_BAR(2);
  s16x4 vlo[8],vhi[8]; u32x4 pw0,pw1,pw2,pw3;
  #define PKW(P,B) cvtpk_s(P[B],P[B+1])
  #define PAF(k) __builtin_bit_cast(bf16x8,pw##k)
  #define VFR(i) (bf16x8){vlo[i][0],vlo[i][1],vlo[i][2],vlo[i][3],vhi[i][0],vhi[i][1],vhi[i][2],vhi[i][3]}
  #define PIN(x) asm volatile("":"+v"(x))
  #define MX3(a,b,c) __builtin_fmaxf(__builtin_fmaxf((a),(b)),(c))
  #define GAPA(MF,A0,A1,A2,A3,W0,W1,PW) do{ MF; sacc+=A0; sacc+=A1; sacc+=A2; sacc+=A3; PIN(sacc); W0; W1; PIN(PW); SBAR(); }while(0)
  #define EX(v) __builtin_amdgcn_exp2f(v)
  #define GAPB(MF,X,B) do{ MF; X[B]=EX(X[B]); X[B+1]=EX(X[B+1]); X[B+2]=EX(X[B+2]); X[B+3]=EX(X[B+3]); PIN(X); SBAR(); }while(0)
  #define VRD(i) do{ vlo[i]=vtr(vp_+(((i)>>2)*4096+((i)&3)*1024)); vhi[i]=vtr(vp_+(((i)>>2)*4096+((i)&3)*1024+512)); }while(0)
  #define KRD(G,j) do{ if(G){ kload2(kf,kp0+sl_next,j); SBAR(); } }while(0)
  #define STEP(C0,C1,P0,P1,t,GK,GV,GL) do{ SBAR(); \
    const lds_cptr vp_=vp0+sl_prev; \
    VRD(0); SBAR(); float sacc=(P0[0]+P0[1]); \
    GAPA(C0=__builtin_amdgcn_mfma_f32_32x32x16_bf16(kf[0],qr[0],negm,0,0,0), P0[2],P0[3],P0[4],P0[5],     pw0[0]=PKW(P0,0), pw0[1]=PKW(P0,2), pw0); \
    VRD(4); SBAR(); GAPA(C1=__builtin_amdgcn_mfma_f32_32x32x16_bf16(kf[1],qr[0],negm,0,0,0), P0[6],P0[7],P0[8],P0[9],     pw0[2]=PKW(P0,4), pw0[3]=PKW(P0,6), pw0); \
    VRD(1); SBAR(); GAPA(C0=__builtin_amdgcn_mfma_f32_32x32x16_bf16(kf[2],qr[1],C0,0,0,0),   P0[10],P0[11],P0[12],P0[13], pw1[0]=PKW(P0,8), pw1[1]=PKW(P0,10), pw1); \
    VRD(5); SBAR(); GAPA(C1=__builtin_amdgcn_mfma_f32_32x32x16_bf16(kf[3],qr[1],C1,0,0,0),   P0[14],P0[15],P1[0],P1[1],   pw1[2]=PKW(P0,12),pw1[3]=PKW(P0,14), pw1); \
    VRD(2); SBAR(); GAPA(C0=__builtin_amdgcn_mfma_f32_32x32x16_bf16(kf[4],qr[2],C0,0,0,0),   P1[2],P1[3],P1[4],P1[5],     pw2[0]=PKW(P1,0), pw2[1]=PKW(P1,2), pw2); \
    VRD(6); SBAR(); GAPA(C1=__builtin_amdgcn_mfma_f32_32x32x16_bf16(kf[5],qr[2],C1,0,0,0),   P1[6],P1[7],P1[8],P1[9],     pw2[2]=PKW(P1,4), pw2[3]=PKW(P1,6), pw2); \
    VRD(3); SBAR(); GAPA(C0=__builtin_amdgcn_mfma_f32_32x32x16_bf16(kf[6],qr[3],C0,0,0,0),   P1[10],P1[11],P1[12],P1[13], pw3[0]=PKW(P1,8), pw3[1]=PKW(P1,10), pw3); \
    VRD(7); SBAR(); GAPA(C1=__builtin_amdgcn_mfma_f32_32x32x16_bf16(kf[7],qr[3],C1,0,0,0),   P1[14],P1[15],0.f,0.f,       pw3[2]=PKW(P1,12),pw3[3]=PKW(P1,14), pw3); \
    l_reg+=sacc; \
    if(GK){DMA_K((t)+3,sl_cur);} if(GV){DMA_V((t)+1,sl_next);} \
    CMASK(C0,C1,t); \
    { float a=MX3(C0[0],C0[1],C1[0]),b=MX3(C0[2],C0[3],C1[1]); a=MX3(a,C1[2],C1[3]); \
      _Pragma("unroll") for(int r=4;r<16;r+=4){a=MX3(a,C0[r],C0[r+1]);b=MX3(b,C0[r+2],C0[r+3]);a=MX3(a,C1[r],C1[r+1]);b=MX3(b,C1[r+2],C1[r+3]);} \
      float rm=__builtin_fmaxf(a,b); { auto rr=__builtin_amdgcn_permlane32_swap(__float_as_uint(rm),__float_as_uint(rm),false,false); rm=__builtin_fmaxf(__uint_as_float(rr[0]),__uint_as_float(rr[1])); } \
      resc=false; \
      if(__builtin_expect(__any(rm>(float)THRL),0)){ const float dl=__builtin_fmaxf(rm,0.f); mhat+=dl; \
        _Pragma("unroll") for(int r=0;r<16;++r){C0[r]-=dl;C1[r]-=dl;} \
        _Pragma("unroll") for(int r=0;r<16;++r)negm[r]=-mhat; asm volatile("":"+v"(negm)); \
        const float f=__builtin_amdgcn_exp2f(-dl); l_reg*=f; if(hi==0)wsf[r32]=f; resc=true; } } \
    SBAR(); \
    GAPB(o[0]=__builtin_amdgcn_mfma_f32_32x32x16_bf16(PAF(0),VFR(0),o[0],0,0,0), C0,0); \
    GAPB(o[1]=__builtin_amdgcn_mfma_f32_32x32x16_bf16(PAF(0),VFR(4),o[1],0,0,0), C0,4); \
    KRD(GL,0); GAPB(o[0]=__builtin_amdgcn_mfma_f32_32x32x16_bf16(PAF(1),VFR(1),o[0],0,0,0), C0,8); \
    KRD(GL,1); GAPB(o[1]=__builtin_amdgcn_mfma_f32_32x32x16_bf16(PAF(1),VFR(5),o[1],0,0,0), C0,12); \
    KRD(GL,2); GAPB(o[0]=__builtin_amdgcn_mfma_f32_32x32x16_bf16(PAF(2),VFR(2),o[0],0,0,0), C1,0); \
    KRD(GL,3); GAPB(o[1]=__builtin_amdgcn_mfma_f32_32x32x16_bf16(PAF(2),VFR(6),o[1],0,0,0), C1,4); \
    GAPB(o[0]=__builtin_amdgcn_mfma_f32_32x32x16_bf16(PAF(3),VFR(3),o[0],0,0,0), C1,8); \
    GAPB(o[1]=__builtin_amdgcn_mfma_f32_32x32x16_bf16(PAF(3),VFR(7),o[1],0,0,0), C1,12); \
    }while(0)
  int t=1;
  #undef CMASK
  #define CMASK(P0,P1,t) do{}while(0)
  for(;t+5<NT;t+=2){
    STEP(pB0,pB1,pA0,pA1,t,true,true,true);     WAIT_BAR(2); RESC(); ROT();
    STEP(pA0,pA1,pB0,pB1,t+1,true,true,true);   WAIT_BAR(2); RESC(); ROT();
  }
  #undef CMASK
  #define CMASK(P0,P1,t) do{int jb_=(t)-(NT-4); if(jb_>=0)cmask(P0,P1,jb_,qrel,hi);}while(0)
  #define ENDW(tt) do{ if((tt)+3<NT){WAIT_BAR(2);} else if((tt)+2<NT){WAIT_BAR(1);} else {WAIT_BAR(0);} }while(0)
  for(;t+1<NT;t+=2){
    STEP(pB0,pB1,pA0,pA1,t,(t+3<NT),(t+1<NT),(t+1<NT));       ENDW(t);   RESC(); ROT();
    STEP(pA0,pA1,pB0,pB1,t+1,(t+4<NT),(t+2<NT),(t+2<NT));     ENDW(t+1); RESC(); ROT();
  }
  STEP(pB0,pB1,pA0,pA1,NT-1,false,false,false); RESC();
  { float sacc=pB0[0]+pB0[1]; _Pragma("unroll") for(int r=2;r<16;++r)sacc+=pB0[r]; _Pragma("unroll") for(int r=0;r<16;++r)sacc+=pB1[r]; l_reg+=sacc;
    pw0=(u32x4){PKW(pB0,0),PKW(pB0,2),PKW(pB0,4),PKW(pB0,6)};pw1=(u32x4){PKW(pB0,8),PKW(pB0,10),PKW(pB0,12),PKW(pB0,14)};pw2=(u32x4){PKW(pB1,0),PKW(pB1,2),PKW(pB1,4),PKW(pB1,6)};pw3=(u32x4){PKW(pB1,8),PKW(pB1,10),PKW(pB1,12),PKW(pB1,14)};
    SBAR(); pv(o,vb0+sl_cur,PAF(0),PAF(1),PAF(2),PAF(3)); }
  #undef PKW
  #undef PAF
  #undef VFR
  #undef PIN
  #undef MX3
  #undef GAPA
  #undef GAPB
  #undef EX
  #undef VRD
  #undef KRD
  #undef STEP
  #undef ENDW
  {auto rr=__builtin_amdgcn_permlane32_swap(__float_as_uint(l_reg),__float_as_uint(l_reg),false,false);l_reg=__uint_as_float(rr[0])+__uint_as_float(rr[1]);}
  if(hi==0)wsf[32+r32]=l_reg;asm volatile("s_waitcnt lgkmcnt(0)":::"memory");
  float rli[16];
  #pragma unroll
  for(int r=0;r<16;++r)rli[r]=__builtin_amdgcn_rcpf(wsf[32+crow(r,hi)]);
  bf16*Ow=O+(rowbase+q0+wid*QBLK)*DM+hv*D;
  { bf16*stg=(bf16*)(shm+LDS_OST)+wid*2048;
    #pragma unroll
    for(int r=0;r<16;++r){const int orow=crow(r,hi);
      #pragma unroll
      for(int d0=0;d0<2;++d0)stg[orow*64+d0*32+r32]=__float2bfloat16(o[d0][r]*rli[r]);}
    asm volatile("s_waitcnt lgkmcnt(0)":::"memory");
    #pragma unroll
    for(int i=0;i<4;++i){const int row=i*8+(lane>>3),ch=lane&7; const u32x4 v=*(const u32x4*)(stg+row*64+ch*8); ATTN_STORE16(Ow+(long)row*DM+ch*8,v);} }
  asm volatile("s_waitcnt lgkmcnt(0)\n\ts_barrier":::"memory");
  #undef DMA_K
  #undef DMA_V
  #undef CMASK
  #undef START
  #undef RESC
  #undef ROT
}
__device__ __forceinline__ void pv4(f32x16*o,int vb,bf16x8 pa0,bf16x8 pa1,bf16x8 pa2,bf16x8 pa3){
  #pragma unroll
  for(int d0=0;d0<4;++d0){s16x4 lo[4],hi[4];
    #pragma unroll
    for(int ks=0;ks<4;++ks){
      asm volatile("ds_read_b64_tr_b16 %0,%1 offset:%c2":"=&v"(lo[ks]):"v"(vb),"i"(d0*4096+ks*1024):"memory");
      asm volatile("ds_read_b64_tr_b16 %0,%1 offset:%c2":"=&v"(hi[ks]):"v"(vb),"i"(d0*4096+ks*1024+512):"memory");}
    asm volatile("s_waitcnt lgkmcnt(0)":::"memory");SBAR();
    #define PK(k) (bf16x8){lo[k][0],lo[k][1],lo[k][2],lo[k][3],hi[k][0],hi[k][1],hi[k][2],hi[k][3]}
    o[d0]=__builtin_amdgcn_mfma_f32_32x32x16_bf16(pa0,PK(0),o[d0],0,0,0);
    o[d0]=__builtin_amdgcn_mfma_f32_32x32x16_bf16(pa1,PK(1),o[d0],0,0,0);
    o[d0]=__builtin_amdgcn_mfma_f32_32x32x16_bf16(pa2,PK(2),o[d0],0,0,0);
    o[d0]=__builtin_amdgcn_mfma_f32_32x32x16_bf16(pa3,PK(3),o[d0],0,0,0);
    #undef PK
  }
}
constexpr int L2_K=0, L2_V=NSLOT*SLOTB, L2_WS=L2_V+NSLOT*2*SLOTB, L2_OST=L2_WS+NW*64*4, L2_BYTES=L2_OST+NW*8192;
template<int THRL> __device__ __forceinline__ void attn_pass128(int tid,int b,int h,int hv,int qb,const bf16*Q,const bf16*__restrict__ K,const bf16*__restrict__ V,char*shm,const bool pre,bf16x8 (&qr)[4]){
  const int lane=tid&63,r32=lane&31,hi=lane>>5; const int wid=__builtin_amdgcn_readfirstlane(tid>>6);
  const long rowbase=(long)b*SEQ; const int q0=qb*QB;
  const bf16*Qw=Q+(rowbase+q0+wid*QBLK)*DM+h*D;
  const bf16*Kh=K+rowbase*DM+h*D,*Vh=V+rowbase*DM+hv*128;
  const unsigned lds0=(unsigned)(uintptr_t)shm;
  float*wsf=(float*)(shm+L2_WS)+wid*64;
  const unsigned ksrc=(unsigned)(lane*DM+wid*8)*2u;
  const unsigned vsrc=(unsigned)((16*(wid&3)+(lane>>2))*DM+(wid>>2)*32+(lane&3)*8)*2u;
  const unsigned kdst=lds0+L2_K+wid*1024, vdst=lds0+L2_V+wid*1024;
  #define DMA_K(t,slot) glds16(Kh+(long)(t)*KVBLK*DM,ksrc,(unsigned)__builtin_amdgcn_readfirstlane(kdst+(slot)))
  #define DMA_V(t,slot) do{ glds16(Vh+(long)(t)*KVBLK*DM,vsrc,(unsigned)__builtin_amdgcn_readfirstlane(vdst+2*(slot))); glds16(Vh+(long)(t)*KVBLK*DM+64,vsrc,(unsigned)__builtin_amdgcn_readfirstlane(vdst+2*(slot)+8192)); }while(0)
  const int vb0=(int)(lds0+L2_V)+((lane>>4)&1)*32+(lane&3)*8+(4*hi+((lane&15)>>2))*64;
  const char*Kbase=shm+L2_K; bf16x8 kf[8];
  const lds_cptr shm3=(lds_cptr)shm; const lds_cptr kp0=shm3+L2_K+hi*1024+r32*16; const lds_cptr vp0=shm3+L2_V+((lane>>4)&1)*32+(lane&3)*8+(4*hi+((lane&15)>>2))*64;
  const int NT=(q0+QB)/KVBLK;
  if(!pre){ DMA_K(0,0);DMA_V(0,0);DMA_K(1,SLOTB);
    #pragma unroll
    for(int d0=0;d0<4;++d0)qr[d0]=*reinterpret_cast<const bf16x8*>(&Qw[(long)r32*DM+d0*16+hi*8]); }
  float mhat=0.f,l_reg=0.f;f32x16 o[4];o[0]=f32x16{};o[1]=f32x16{};o[2]=f32x16{};o[3]=f32x16{}; const f32x16 zero16=f32x16{};
  const int qrel=wid*QBLK+r32;
  #define CMASK(P0,P1,t) do{int jb_=(t)-(NT-4); if(jb_>=0)cmask(P0,P1,jb_,qrel,hi);}while(0)
  bool resc=false;
  #define START(P0,P1) do{ const float rm=rowmax(P0,P1); resc=false; mhat=fadd_s(mhat,rm); \
    _Pragma("unroll") for(int r=0;r<16;++r)P0[r]=__builtin_amdgcn_exp2f(fsub_s(P0[r],mhat)); }while(0)
  #define RESC() do{ if(resc){ asm volatile("s_waitcnt lgkmcnt(0)":::"memory"); \
      _Pragma("unroll") for(int d_=0;d_<4;++d_) _Pragma("unroll") for(int r=0;r<16;++r)o[d_][r]*=wsf[crow(r,hi)]; } }while(0)
  f32x16 pA0,pA1,pB0,pB1;
  int sl_prev=0,sl_cur=0,sl_next=SLOTB;
  #define ROT() do{sl_prev=sl_cur;sl_cur=sl_next;sl_next=(sl_next==(NSLOT-1)*SLOTB)?0:sl_next+SLOTB;}while(0)
  if(!pre){ DMA_K(2,2*SLOTB);
    WAIT_BAR(4); }
  else { WAIT_BAR(12); }
  qkt(pA0,pA1,Kbase,qr,zero16,r32,hi);asm volatile("s_nop 15\n\ts_nop 7":"+v"(pA0),"+v"(pA1));CMASK(pA0,pA1,0);
  START(pA0,pA1);
  _Pragma("unroll") for(int r=0;r<16;++r)pA1[r]=__builtin_amdgcn_exp2f(fsub_s(pA1[r],mhat));
  WAIT_BAR(0);
  DMA_K(3,0);DMA_V(1,SLOTB);
  ROT();
  kload8(kf,kp0+sl_cur);
  WAIT_BAR(3);
  s16x4 vlo[8],vhi[8]; u32x4 pw0,pw1,pw2,pw3;
  #define PKW(P,B) cvtpk_s(P[B],P[B+1])
  #define PAF(k) __builtin_bit_cast(bf16x8,pw##k)
  #define VFR(i) (bf16x8){vlo[i][0],vlo[i][1],vlo[i][2],vlo[i][3],vhi[i][0],vhi[i][1],vhi[i][2],vhi[i][3]}
  #define PIN(x) asm volatile("":"+v"(x))
  #define MX3(a,b,c) __builtin_fmaxf(__builtin_fmaxf((a),(b)),(c))
  #define GAPA(MF,A0,A1,A2,A3,W0,W1,PW) do{ MF; sacc+=A0; sacc+=A1; sacc+=A2; sacc+=A3; PIN(sacc); W0; W1; PIN(PW); SBAR(); }while(0)
  #define EX(v) __builtin_amdgcn_exp2f(fsub_s((v),mhat))
  #define VRDX(i,f) do{ vlo[i]=vtr(vp_+(((f)>>2)*4096+((f)&3)*1024)); vhi[i]=vtr(vp_+(((f)>>2)*4096+((f)&3)*1024+512)); }while(0)
  #define GAPB(MF,X,B,RL) do{ MF; { const float a_=X[B]-mhat, b_=X[B+1]-mhat; X[B]=__builtin_amdgcn_exp2f(a_); X[B+1]=__builtin_amdgcn_exp2f(b_); } RL; PIN(X); SBAR(); }while(0)
  #define VRD(i) do{ vlo[i]=vtr(vp_+(((i)>>2)*4096+((i)&3)*1024)); vhi[i]=vtr(vp_+(((i)>>2)*4096+((i)&3)*1024+512)); }while(0)
  #define KRD(G,j) do{ if(G){ kload2(kf,kp0+sl_next,j); SBAR(); } }while(0)
  #define STEP(C0,C1,P0,P1,t,GK,GV,GL) do{ SBAR(); \
    const lds_cptr vp_=vp0+2*sl_prev; \
    VRD(0); SBAR(); float sacc=(P0[0]+P0[1]); \
    GAPA(C0=__builtin_amdgcn_mfma_f32_32x32x16_bf16(kf[0],qr[0],zero16,0,0,0), P0[2],P0[3],P0[4],P0[5],     pw0[0]=PKW(P0,0), pw0[1]=PKW(P0,2), pw0); \
    VRD(4); SBAR(); GAPA(C1=__builtin_amdgcn_mfma_f32_32x32x16_bf16(kf[1],qr[0],zero16,0,0,0), P0[6],P0[7],P0[8],P0[9],     pw0[2]=PKW(P0,4), pw0[3]=PKW(P0,6), pw0); \
    VRD(1); SBAR(); GAPA(C0=__builtin_amdgcn_mfma_f32_32x32x16_bf16(kf[2],qr[1],C0,0,0,0),   P0[10],P0[11],P0[12],P0[13], pw1[0]=PKW(P0,8), pw1[1]=PKW(P0,10), pw1); \
    VRD(5); SBAR(); GAPA(C1=__builtin_amdgcn_mfma_f32_32x32x16_bf16(kf[3],qr[1],C1,0,0,0),   P0[14],P0[15],P1[0],P1[1],   pw1[2]=PKW(P0,12),pw1[3]=PKW(P0,14), pw1); \
    VRD(2); SBAR(); GAPA(C0=__builtin_amdgcn_mfma_f32_32x32x16_bf16(kf[4],qr[2],C0,0,0,0),   P1[2],P1[3],P1[4],P1[5],     pw2[0]=PKW(P1,0), pw2[1]=PKW(P1,2), pw2); \
    VRD(6); SBAR(); GAPA(C1=__builtin_amdgcn_mfma_f32_32x32x16_bf16(kf[5],qr[2],C1,0,0,0),   P1[6],P1[7],P1[8],P1[9],     pw2[2]=PKW(P1,4), pw2[3]=PKW(P1,6), pw2); \
    VRD(3); SBAR(); GAPA(C0=__builtin_amdgcn_mfma_f32_32x32x16_bf16(kf[6],qr[3],C0,0,0,0),   P1[10],P1[11],P1[12],P1[13], pw3[0]=PKW(P1,8), pw3[1]=PKW(P1,10), pw3); \
    VRD(7); SBAR(); GAPA(C1=__builtin_amdgcn_mfma_f32_32x32x16_bf16(kf[7],qr[3],C1,0,0,0),   P1[14],P1[15],0.f,0.f,       pw3[2]=PKW(P1,12),pw3[3]=PKW(P1,14), pw3); \
    l_reg+=sacc; \
    if(GK){DMA_K((t)+3,sl_cur);} if(GV){DMA_V((t)+1,sl_next);} \
    CMASK(C0,C1,t); \
    { float a=MX3(C0[0],C0[1],C1[0]),b=MX3(C0[2],C0[3],C1[1]); a=MX3(a,C1[2],C1[3]); \
      _Pragma("unroll") for(int r=4;r<16;r+=4){a=MX3(a,C0[r],C0[r+1]);b=MX3(b,C0[r+2],C0[r+3]);a=MX3(a,C1[r],C1[r+1]);b=MX3(b,C1[r+2],C1[r+3]);} \
      float rm=__builtin_fmaxf(a,b); { auto rr=__builtin_amdgcn_permlane32_swap(__float_as_uint(rm),__float_as_uint(rm),false,false); rm=__builtin_fmaxf(__uint_as_float(rr[0]),__uint_as_float(rr[1])); } \
      resc=false; \
      rm-=mhat; \
      if(__builtin_expect(__any(rm>(float)THRL),0)){ const float dl=__builtin_fmaxf(rm,0.f); mhat+=dl; \
        const float f=__builtin_amdgcn_exp2f(-dl); l_reg*=f; if(hi==0)wsf[r32]=f; resc=true; } } \
    SBAR(); \
    GAPB(o[0]=__builtin_amdgcn_mfma_f32_32x32x16_bf16(PAF(0),VFR(0),o[0],0,0,0), C0,0,  VRDX(0,8)); \
    GAPB(o[1]=__builtin_amdgcn_mfma_f32_32x32x16_bf16(PAF(0),VFR(4),o[1],0,0,0), C0,2,  VRDX(4,12)); \
    KRD(GL,0); GAPB(o[0]=__builtin_amdgcn_mfma_f32_32x32x16_bf16(PAF(1),VFR(1),o[0],0,0,0), C0,4,  VRDX(1,9)); \
    KRD(GL,1); GAPB(o[1]=__builtin_amdgcn_mfma_f32_32x32x16_bf16(PAF(1),VFR(5),o[1],0,0,0), C0,6,  VRDX(5,13)); \
    KRD(GL,2); GAPB(o[0]=__builtin_amdgcn_mfma_f32_32x32x16_bf16(PAF(2),VFR(2),o[0],0,0,0), C0,8,  VRDX(2,10)); \
    KRD(GL,3); GAPB(o[1]=__builtin_amdgcn_mfma_f32_32x32x16_bf16(PAF(2),VFR(6),o[1],0,0,0), C0,10, VRDX(6,14)); \
    GAPB(o[0]=__builtin_amdgcn_mfma_f32_32x32x16_bf16(PAF(3),VFR(3),o[0],0,0,0), C0,12, VRDX(3,11)); \
    GAPB(o[1]=__builtin_amdgcn_mfma_f32_32x32x16_bf16(PAF(3),VFR(7),o[1],0,0,0), C0,14, VRDX(7,15)); \
    GAPB(o[2]=__builtin_amdgcn_mfma_f32_32x32x16_bf16(PAF(0),VFR(0),o[2],0,0,0), C1,0,  (void)0); \
    GAPB(o[3]=__builtin_amdgcn_mfma_f32_32x32x16_bf16(PAF(0),VFR(4),o[3],0,0,0), C1,2,  (void)0); \
    GAPB(o[2]=__builtin_amdgcn_mfma_f32_32x32x16_bf16(PAF(1),VFR(1),o[2],0,0,0), C1,4,  (void)0); \
    GAPB(o[3]=__builtin_amdgcn_mfma_f32_32x32x16_bf16(PAF(1),VFR(5),o[3],0,0,0), C1,6,  (void)0); \
    GAPB(o[2]=__builtin_amdgcn_mfma_f32_32x32x16_bf16(PAF(2),VFR(2),o[2],0,0,0), C1,8,  (void)0); \
    GAPB(o[3]=__builtin_amdgcn_mfma_f32_32x32x16_bf16(PAF(2),VFR(6),o[3],0,0,0), C1,10, (void)0); \
    GAPB(o[2]=__builtin_amdgcn_mfma_f32_32x32x16_bf16(PAF(3),VFR(3),o[2],0,0,0), C1,12, (void)0); \
    GAPB(o[3]=__builtin_amdgcn_mfma_f32_32x32x16_bf16(PAF(3),VFR(7),o[3],0,0,0), C1,14, (void)0); \
    }while(0)
  int t=1;
  #undef CMASK
  #define CMASK(P0,P1,t) do{}while(0)
  for(;t+5<NT;t+=2){
    STEP(pB0,pB1,pA0,pA1,t,true,true,true);     WAIT_BAR(3); RESC(); ROT();
    STEP(pA0,pA1,pB0,pB1,t+1,true,true,true);   WAIT_BAR(3); RESC(); ROT();
  }
  #undef CMASK
  #define CMASK(P0,P1,t) do{int jb_=(t)-(NT-4); if(jb_>=0)cmask(P0,P1,jb_,qrel,hi);}while(0)
  #define ENDW(tt) do{ if((tt)+3<NT){WAIT_BAR(3);} else if((tt)+2<NT){WAIT_BAR(2);} else {WAIT_BAR(0);} }while(0)
  for(;t+1<NT;t+=2){
    STEP(pB0,pB1,pA0,pA1,t,(t+3<NT),(t+1<NT),(t+1<NT));       ENDW(t);   RESC(); ROT();
    STEP(pA0,pA1,pB0,pB1,t+1,(t+4<NT),(t+2<NT),(t+2<NT));     ENDW(t+1); RESC(); ROT();
  }
  STEP(pB0,pB1,pA0,pA1,NT-1,false,false,false); RESC();
  { float sacc=pB0[0]+pB0[1]; _Pragma("unroll") for(int r=2;r<16;++r)sacc+=pB0[r]; _Pragma("unroll") for(int r=0;r<16;++r)sacc+=pB1[r]; l_reg+=sacc;
    pw0=(u32x4){PKW(pB0,0),PKW(pB0,2),PKW(pB0,4),PKW(pB0,6)};pw1=(u32x4){PKW(pB0,8),PKW(pB0,10),PKW(pB0,12),PKW(pB0,14)};pw2=(u32x4){PKW(pB1,0),PKW(pB1,2),PKW(pB1,4),PKW(pB1,6)};pw3=(u32x4){PKW(pB1,8),PKW(pB1,10),PKW(pB1,12),PKW(pB1,14)};
    SBAR(); pv4(o,vb0+2*sl_cur,PAF(0),PAF(1),PAF(2),PAF(3)); }
  #undef PKW
  #undef PAF
  #undef VFR
  #undef PIN
  #undef MX3
  #undef GAPA
  #undef GAPB
  #undef EX
  #undef VRD
  #undef VRDX
  #undef KRD
  #undef STEP
  #undef ENDW
  {auto rr=__builtin_amdgcn_permlane32_swap(__float_as_uint(l_reg),__float_as_uint(l_reg),false,false);l_reg=__uint_as_float(rr[0])+__uint_as_float(rr[1]);}
  if(hi==0)wsf[32+r32]=l_reg;asm volatile("s_waitcnt lgkmcnt(0)":::"memory");
  float rli[16];
  #pragma unroll
  for(int r=0;r<16;++r)rli[r]=__builtin_amdgcn_rcpf(wsf[32+crow(r,hi)]);
  { bf16*stg=(bf16*)(shm+L2_OST)+wid*4096;
    #pragma unroll
    for(int r=0;r<16;++r){const int orow=crow(r,hi);
      #pragma unroll
      for(int d0=0;d0<4;++d0)stg[orow*128+d0*32+r32]=__float2bfloat16(o[d0][r]*rli[r]);} }
  asm volatile("s_waitcnt lgkmcnt(0)\n\ts_barrier":::"memory");
  #undef DMA_K
  #undef DMA_V
  #undef CMASK
  #undef START
  #undef RESC
  #undef ROT
}

__device__ __forceinline__ void attn_pro128(int tid,int b,int h,int hv,int qb,const bf16*Q,const bf16*__restrict__ K,const bf16*__restrict__ V,char*shm,bf16x8 (&qr)[4]){
  const int lane=tid&63,r32=lane&31,hi=lane>>5; const int wid=__builtin_amdgcn_readfirstlane(tid>>6);
  const long rowbase=(long)b*SEQ; const int q0=qb*QB;
  const bf16*Qw=Q+(rowbase+q0+wid*QBLK)*DM+h*D;
  const bf16*Kh=K+rowbase*DM+h*D,*Vh=V+rowbase*DM+hv*128;
  const unsigned lds0=(unsigned)(uintptr_t)shm;
  const unsigned ksrc=(unsigned)(lane*DM+wid*8)*2u;
  const unsigned vsrc=(unsigned)((16*(wid&3)+(lane>>2))*DM+(wid>>2)*32+(lane&3)*8)*2u;
  const unsigned kdst=lds0+L2_K+wid*1024, vdst=lds0+L2_V+wid*1024;
  glds16(Kh,ksrc,(unsigned)__builtin_amdgcn_readfirstlane(kdst));
  glds16(Vh,vsrc,(unsigned)__builtin_amdgcn_readfirstlane(vdst)); glds16(Vh+64,vsrc,(unsigned)__builtin_amdgcn_readfirstlane(vdst+8192));
  glds16(Kh+(long)KVBLK*DM,ksrc,(unsigned)__builtin_amdgcn_readfirstlane(kdst+SLOTB));
  #pragma unroll
  for(int d0=0;d0<4;++d0)qr[d0]=*reinterpret_cast<const bf16x8*>(&Qw[(long)r32*DM+d0*16+hi*8]);
  glds16(Kh+(long)2*KVBLK*DM,ksrc,(unsigned)__builtin_amdgcn_readfirstlane(kdst+2*SLOTB));
}
template<int THRL> __device__ __forceinline__ void diff_cu128(int tid,int b,int h,int s_,const bf16*Q,const bf16*K,const bf16*V,bf16*park,bf16*AO,float lam,const float*subln,float sc,char*shm){
  bf16x8 qr[4]; bool pre=false;
  #pragma unroll 1
  for(int p=0;p<8;++p){
    const int i=p>>1,mp=p&1; const int qb= i==0?15-s_: i==1?8+s_: i==2?7-s_: s_;
    attn_pass128<THRL>(tid,b,2*h+mp,h,qb,Q,K,V,shm,pre,qr);
    const bool hn=p+1<8; const int ni=(p+1)>>1,nmp=(p+1)&1; const int nqb= ni==0?15-s_: ni==1?8+s_: ni==2?7-s_: s_;
    int t2=tid; asm volatile("":"+v"(t2));
    const int lane=t2&63; const int wid=__builtin_amdgcn_readfirstlane(t2>>6);
    const long row0=(long)b*SEQ+qb*QB+wid*QBLK;
    const char*stg=shm+L2_OST+wid*8192+(lane>>4)*256+(lane&15)*16;
    const unsigned goff=(unsigned)(((lane>>4)*DM+h*128+(lane&15)*8)*2);
    char*pk=(char*)(park+row0*DM); char*ao=(char*)(AO+row0*DM);
    if(mp==0){
      if(hn)attn_pro128(t2,b,2*h+nmp,h,nqb,Q,K,V,shm,qr);
      #pragma unroll 2
      for(int i2=0;i2<8;++i2){ const u32x4 v=*(const u32x4*)(stg+i2*1024); *(u32x4*)(pk+goff+(unsigned)i2*(4*DM*2))=v; }
    } else {
      float sl[8];
      #pragma unroll
      for(int j=0;j<8;++j)sl[j]=subln[(lane&15)*8+j]*sc;
      u32x4 v0a[8];
      #pragma unroll
      for(int i2=0;i2<8;++i2)v0a[i2]=*(const u32x4*)(pk+goff+(unsigned)i2*(4*DM*2));
      #pragma unroll
      for(int i2=0;i2<8;++i2)asm volatile("":"+v"(v0a[i2]));
      if(hn)attn_pro128(t2,b,2*h+nmp,h,nqb,Q,K,V,shm,qr);
      #pragma unroll
      for(int i2=0;i2<8;++i2){ const u32x4 v1=*(const u32x4*)(stg+i2*1024); const u32x4 v0=v0a[i2];
        float d[8];
        #pragma unroll
        for(int j=0;j<4;++j){ d[2*j]=__uint_as_float(v0[j]<<16)-lam*__uint_as_float(v1[j]<<16); d[2*j+1]=__uint_as_float(v0[j]&0xffff0000u)-lam*__uint_as_float(v1[j]&0xffff0000u); }
        float ss=0.f;
        #pragma unroll
        for(int j=0;j<8;++j)ss+=d[j]*d[j];
        ss+=__shfl_xor(ss,1);ss+=__shfl_xor(ss,2);ss+=__shfl_xor(ss,4);ss+=__shfl_xor(ss,8);
        const float rn=__builtin_amdgcn_rsqf(ss*(1.f/128.f)+1e-6f);
        u32x4 w;
        #pragma unroll
        for(int j=0;j<4;++j)w[j]=cvtpk_s(d[2*j]*rn*sl[2*j],d[2*j+1]*rn*sl[2*j+1]);
        *(u32x4*)(ao+goff+(unsigned)i2*(4*DM*2))=w;}
    }
    asm volatile("s_waitcnt lgkmcnt(0)":::"memory");
    pre=hn;
  }
}
constexpr int ATTN_LDS_BYTES=LDS_BYTES;
#undef SBAR
#undef WAIT_BAR
}

__device__ __forceinline__ void attn_diff_fast(const int tid, unsigned char* lds_raw, const Args& A) {
    const int G = gridDim.x, bx = blockIdx.x; const int vcu0 = (G % 8 == 0) ? (bx % 8) * (G / 8) + bx / 8 : bx;
    const attn_body::bf16* Q = (const attn_body::bf16*)(A.ws + WS_Q); const attn_body::bf16* K = (const attn_body::bf16*)(A.ws + WS_K); const attn_body::bf16* V = (const attn_body::bf16*)(A.ws + WS_V);
    attn_body::bf16* O0 = (attn_body::bf16*)A.out; attn_body::bf16* O1 = O0 + (size_t)T * DM;
    for (int v = vcu0; v < 256; v += G) {
        const int bh = v >> 2, s_ = v & 3, b = bh >> 3, h = bh & 7;
#pragma unroll 1
        for (int i = 0; i < 16; ++i) {
            const int combo = i & 3, qsel = i >> 2, m = combo >> 1, vh = combo & 1;
            const int qb = qsel == 0 ? 15 - s_ : qsel == 1 ? 8 + s_ : qsel == 2 ? 7 - s_ : s_;
            attn_body::attn_unit<8>(tid, b, h * 2 + m, h * 2 + vh, qb, Q, K, V, m ? O1 : O0, (char*)lds_raw);
        }
    }
}
__device__ __forceinline__ void attn_diff_fast2(const int tid, unsigned char* lds_raw, const Args& A) {
    const int G = gridDim.x, bx = blockIdx.x; const int vcu0 = (G % 8 == 0) ? (bx % 8) * (G / 8) + bx / 8 : bx; const int lane = tid & 63;
    const attn_body::bf16* Q = (const attn_body::bf16*)(A.ws + WS_Q); const attn_body::bf16* K = (const attn_body::bf16*)(A.ws + WS_K); const attn_body::bf16* V = (const attn_body::bf16*)(A.ws + WS_V);
    attn_body::bf16* park = (attn_body::bf16*)A.out; attn_body::bf16* AO = (attn_body::bf16*)(A.ws + WS_AO);
    const float d1 = A.a_lq1[lane] * A.a_lk1[lane], d2 = A.a_lq2[lane] * A.a_lk2[lane];
    const float lam = __uint_as_float(__builtin_amdgcn_readfirstlane(__float_as_uint(__expf(wave_sum(d1)) - __expf(wave_sum(d2)) + 0.2f)));
    for (int v = vcu0; v < 256; v += G) {
        const int bh = v >> 2, s_ = v & 3, b = bh >> 3, h = bh & 7;
        attn_body::diff_cu128<8>(tid, b, h, s_, Q, K, V, park, AO, lam, A.a_subln, 0.8f, (char*)lds_raw);
    }
}
__device__ __forceinline__ void diff_combine(Frame& F, const Args& A) {
    const int lane = F.lane;
    const float d1 = A.a_lq1[lane] * A.a_lk1[lane], d2 = A.a_lq2[lane] * A.a_lk2[lane];
    const float lam = __expf(wave_sum(d1)) - __expf(wave_sum(d2)) + 0.2f;
    const bf16_t* O0 = (const bf16_t*)A.out; const bf16_t* O1 = O0 + (size_t)T * DM; bf16_t* AO = (bf16_t*)(F.ws + WS_AO);
    float sl[16];
#pragma unroll
    for (int j = 0; j < 16; ++j) sl[j] = A.a_subln[16 * (lane & 7) + j] * 0.8f;
    const int gw = F.vcu * NWAVES + F.wave, NGW = F.G * NWAVES;
    for (int row = gw; row < T; row += NGW) {
        const size_t off = (size_t)row * DM + 16 * lane;
        const u32x4 a0 = *(const u32x4*)(O0 + off), a1 = *(const u32x4*)(O0 + off + 8), b0 = *(const u32x4*)(O1 + off), b1 = *(const u32x4*)(O1 + off + 8);
        float d[16];
#pragma unroll
        for (int j = 0; j < 4; ++j) { d[2 * j] = bflo(a0[j]) - lam * bflo(b0[j]); d[2 * j + 1] = bfhi(a0[j]) - lam * bfhi(b0[j]); d[8 + 2 * j] = bflo(a1[j]) - lam * bflo(b1[j]); d[8 + 2 * j + 1] = bfhi(a1[j]) - lam * bfhi(b1[j]); }
        float ss = 0.f;
#pragma unroll
        for (int j = 0; j < 16; ++j) ss += d[j] * d[j];
        ss += __shfl_xor(ss, 1); ss += __shfl_xor(ss, 2); ss += __shfl_xor(ss, 4);
        const float rn = __builtin_amdgcn_rsqf(ss * (1.f / 128.f) + EPS);
        u32x4 w0, w1;
#pragma unroll
        for (int j = 0; j < 4; ++j) { w0[j] = cvtpk(d[2 * j] * rn * sl[2 * j], d[2 * j + 1] * rn * sl[2 * j + 1]); w1[j] = cvtpk(d[8 + 2 * j] * rn * sl[8 + 2 * j], d[8 + 2 * j + 1] * rn * sl[8 + 2 * j + 1]); }
        *(u32x4*)(AO + off) = w0; *(u32x4*)(AO + off + 8) = w1;
    }
}

constexpr int LDS_RT = 131072 + 8448;
__device__ __forceinline__ void sb_glds16(const void* sbase, unsigned voff, unsigned lds_dst) { unsigned keep;
    asm volatile("s_nop 4\n\ts_mov_b32 %0, m0\n\ts_mov_b32 m0, %3\n\ts_nop 0\n\tglobal_load_lds_dwordx4 %1, %2\n\ts_mov_b32 m0, %0" : "=&s"(keep) : "v"(voff), "s"(sbase), "s"(lds_dst) : "memory"); }
__device__ __forceinline__ void router_phase(Frame& F, const Args& A, int layer) {
    const int lane = F.lane, r16 = lane & 15, kq = lane >> 4;
    LAS unsigned* hist = (LAS unsigned*)(F.lds + LDS_RT); LAS unsigned* base = hist + 32;
    const bf16_t* HB = (const bf16_t*)(F.ws + WS_HB); float* RSTD = (float*)(F.ws + WS_RSTD_FF);
    const bf16_t* WRh = (const bf16_t*)(F.ws + WS_WR) + (size_t)(layer * 2 + 0) * 64 * 1024; const bf16_t* WRl = (const bf16_t*)(F.ws + WS_WR) + (size_t)(layer * 2 + 1) * 64 * 1024;
    unsigned* cnt = (unsigned*)(F.ws + WS_CTL) + CW_CNT + layer * 32; int* rowtok = (int*)(F.ws + WS_ROWTOK); float* rowgate = (float*)(F.ws + WS_ROWGATE); float* rowrs = (float*)(F.ws + WS_ROWRS); unsigned* TS = (unsigned*)(F.ws + WS_TOKSLOT);
    const float* bg = A.b_group + layer * NG; const float* be = A.b_expert + layer * NE;
    const unsigned lds0 = (unsigned)(__SIZE_TYPE__)F.lds;
    const unsigned abuf = lds0 + 49152u + (unsigned)F.wave * 8192u;
    unsigned voA[4], voW[3]; int wpc[3];
#pragma unroll
    for (int j = 0; j < 4; ++j) { const int rr = 4 * j + (lane >> 4); voA[j] = (unsigned)(rr * (DM * 2) + (((lane & 15) ^ rr) << 4)); }
#pragma unroll
    for (int i = 0; i < 3; ++i) { const int p = F.wave + 8 * i, hl = p / 12, rg = p % 12, row = 4 * rg + (lane >> 4); wpc[i] = p;
        voW[i] = (unsigned)((hl * 64 * 1024 + row * 1024) * 2 + (((lane & 15) ^ (row & 15)) << 4)); }
    for (int round = F.vcu; round < T / 128; round += F.G) {
        const int row0 = round * 128 + F.wave * 16;
        if (F.tid < 32) hist[F.tid] = 0u;
        const char* src = (const char*)(HB + (size_t)row0 * DM);
#define RT_DMA(c, buf) do { _Pragma("unroll") for (int i_ = 0; i_ < 3; ++i_) sb_glds16((const char*)WRh + (c) * 256, voW[i_], (unsigned)__builtin_amdgcn_readfirstlane((int)(lds0 + (buf) * 24576u + (unsigned)wpc[i_] * 1024u))); \
            _Pragma("unroll") for (int j_ = 0; j_ < 4; ++j_) sb_glds16(src + (c) * 256, voA[j_], (unsigned)__builtin_amdgcn_readfirstlane((int)(abuf + (buf) * 4096u + j_ * 1024u))); } while (0)
        RT_DMA(0, 0);
        f32x4 acc[3] = {(f32x4){0.f, 0.f, 0.f, 0.f}, (f32x4){0.f, 0.f, 0.f, 0.f}, (f32x4){0.f, 0.f, 0.f, 0.f}}; float ssq = 0.f;
#pragma unroll 1
        for (int c = 0; c < 8; ++c) {
            asm volatile("s_waitcnt vmcnt(0) lgkmcnt(0)\n\ts_barrier" ::: "memory");
            if (c + 1 < 8) RT_DMA(c + 1, (c + 1) & 1);
            const LAS unsigned char* ap = F.lds + 49152 + F.wave * 8192 + (c & 1) * 4096 + r16 * 256;
            const LAS unsigned char* wp = F.lds + (c & 1) * 24576 + r16 * 256;
#pragma unroll
            for (int ks = 0; ks < 4; ++ks) {
                const int sw = ((4 * ks + kq) ^ r16) << 4;
                const u32x4 ah = *(const LAS u32x4*)(ap + sw);
#pragma unroll
                for (int i = 0; i < 4; ++i) { const float lo_ = bflo(ah[i]), hi_ = bfhi(ah[i]); ssq += lo_ * lo_ + hi_ * hi_; }
                const bf16x8 ahv = __builtin_bit_cast(bf16x8, ah);
#pragma unroll
                for (int cb = 0; cb < 3; ++cb) {
                    const bf16x8 bh = *(const LAS bf16x8*)(wp + cb * 4096 + sw), bl = *(const LAS bf16x8*)(wp + 12288 + cb * 4096 + sw);
                    acc[cb] = MFMA16(ahv, bh, acc[cb]); acc[cb] = MFMA16(ahv, bl, acc[cb]);
                }
            }
        }
#undef RT_DMA
        LAS unsigned char* slot = F.lds + 49152 + F.wave * 8192;
        ssq += __shfl_xor(ssq, 16); ssq += __shfl_xor(ssq, 32);
        const float rstd = __builtin_amdgcn_rsqf(ssq * (1.f / DM) + EPS);
        LAS float* lg = (LAS float*)slot;
        asm volatile("s_waitcnt lgkmcnt(0)" ::: "memory");
#pragma unroll
        for (int cb = 0; cb < 3; ++cb)
#pragma unroll
            for (int r = 0; r < 4; ++r) lg[(4 * kq + r) * 49 + cb * 16 + r16] = acc[cb][r];
        asm volatile("s_waitcnt lgkmcnt(0)" ::: "memory");
        int e1 = 0, e2 = 0; float g1 = 0.f, g2 = 0.f; unsigned rk1 = 0, rk2 = 0;
        if (lane < 16) {
            const LAS float* lr = lg + lane * 49;
            float gl[4];
#pragma unroll
            for (int j = 0; j < 4; ++j) gl[j] = lr[32 + j] * rstd + bg[j];
            int gi = 0; float gm = gl[0];
#pragma unroll
            for (int j = 1; j < 4; ++j) if (gl[j] > gm) { gm = gl[j]; gi = j; }
            float gsum = 0.f;
#pragma unroll
            for (int j = 0; j < 4; ++j) gsum += __expf(gl[j] - gm);
            const float gwt = 1.f / gsum;
            float el[8];
#pragma unroll
            for (int j = 0; j < 8; ++j) el[j] = lr[gi * 8 + j] * rstd + be[gi * 8 + j];
            int i1 = 0; float m1 = el[0];
#pragma unroll
            for (int j = 1; j < 8; ++j) if (el[j] > m1) { m1 = el[j]; i1 = j; }
            int i2 = -1; float m2 = -3.0e38f;
#pragma unroll
            for (int j = 0; j < 8; ++j) if (j != i1 && el[j] > m2) { m2 = el[j]; i2 = j; }
            const float p2 = __expf(m2 - m1), inv = 1.f / (1.f + p2);
            g1 = gwt * inv; g2 = gwt * p2 * inv; e1 = gi * 8 + i1; e2 = gi * 8 + i2;
        }
        __syncthreads();
        if (lane < 16) { rk1 = __hip_atomic_fetch_add(&hist[e1], 1u, __ATOMIC_RELAXED, __HIP_MEMORY_SCOPE_WORKGROUP); rk2 = __hip_atomic_fetch_add(&hist[e2], 1u, __ATOMIC_RELAXED, __HIP_MEMORY_SCOPE_WORKGROUP); }
        __syncthreads();
        if (F.tid < 32) base[F.tid] = atomicAdd(&cnt[F.tid], hist[F.tid]);
        __syncthreads();
        if (lane < 16) {
            const int row = row0 + lane; const unsigned s1 = base[e1] + rk1, s2 = base[e2] + rk2;
            RSTD[row] = rstd;
            rowtok[e1 * ECAP + s1] = row; rowgate[e1 * ECAP + s1] = g1; rowrs[e1 * ECAP + s1] = rstd; rowtok[e2 * ECAP + s2] = row; rowgate[e2 * ECAP + s2] = g2; rowrs[e2 * ECAP + s2] = rstd;
            TS[2 * row] = ((unsigned)e1 << 16) | s1; TS[2 * row + 1] = ((unsigned)e2 << 16) | s2;
        }
        __syncthreads();
    }
}

#define XB_TMO      128
#define XB_XCNT(j)  (256  + 64 * (j))
#define XB_XSUB(j)  (1280 + 64 * (j))
#define XB_XGEN(j)  (2304 + 64 * (j))
#define XB_TOP      3328
#define XB_TOPGEN   3392
#define XCD_BAR_WORDS 3456
#define XB_SPIN_CAP (1u << 20)
constexpr int CW_BAR = 4096;
constexpr int LDS_XB = LDS_BYTES - 64;
__device__ __forceinline__ unsigned xb_ld(unsigned* p)              { return __hip_atomic_load(p, __ATOMIC_RELAXED, __HIP_MEMORY_SCOPE_AGENT); }
__device__ __forceinline__ unsigned xb_add(unsigned* p, unsigned v) { return __hip_atomic_fetch_add(p, v, __ATOMIC_RELAXED, __HIP_MEMORY_SCOPE_AGENT); }
__device__ __forceinline__ unsigned xb_xcc_id() { return (unsigned)__builtin_amdgcn_s_getreg((3 << 11) | 20) & 0xFu; }
#define XB_SPIN(cond, bar) do { unsigned _sp = 0; while (cond) { __builtin_amdgcn_s_sleep(1); \
    if ((++_sp & 255u) == 0u) { if (xb_ld(&(bar)[XB_TMO])) break; if (_sp > XB_SPIN_CAP) { atomicAdd(&(bar)[XB_TMO], 1u); break; } } } } while (0)
__device__ __forceinline__ void xcd_barrier_complete(unsigned* bar, unsigned x, unsigned& nloc, unsigned& nx) {
    const unsigned G = gridDim.x;
    unsigned sum, cnt, mine, sp = 0u;
    for (;;) {
        sum = 0u; cnt = 0u; mine = 0u;
#pragma unroll
        for (unsigned j = 0; j < 16; ++j) { const unsigned c = xb_ld(&bar[XB_XCNT(j)]); sum += c; cnt += (c > 0u) ? 1u : 0u; mine = (j == x) ? c : mine; }
        if (sum == G) break;
        __builtin_amdgcn_s_sleep(1);
        if ((++sp & 255u) == 0u) { if (xb_ld(&bar[XB_TMO])) break; if (sp > XB_SPIN_CAP) { atomicAdd(&bar[XB_TMO], 1u); break; } }
    }
    nloc = mine > 0u ? mine : 1u; nx = cnt > 0u ? cnt : 1u;
}
__device__ __forceinline__ void xcd_barrier(const int tid, unsigned* bar, volatile LAS unsigned* st) {
    asm volatile("s_waitcnt vmcnt(0)" ::: "memory");
    __syncthreads();
    if (tid == 0) {
        const unsigned x = xb_xcc_id();
        __builtin_amdgcn_s_waitcnt(0);
        unsigned nloc = st[0], nx = st[1];
        if (nloc == 0u) { xcd_barrier_complete(bar, x, nloc, nx); st[0] = nloc; st[1] = nx; }
        const unsigned old = xb_add(&bar[XB_XSUB(x)], 1u);
        const unsigned gen = old / nloc;
        if (old + 1u == (gen + 1u) * nloc) {
            __builtin_amdgcn_fence(__ATOMIC_RELEASE, "agent");
            asm volatile("s_waitcnt vmcnt(0)" ::: "memory");
            const unsigned og = xb_add(&bar[XB_TOP], 1u);
            const unsigned tg = og / nx;
            if (og + 1u == (tg + 1u) * nx) xb_add(&bar[XB_TOPGEN], 1u);
            else XB_SPIN(xb_ld(&bar[XB_TOPGEN]) == tg, bar);
            __builtin_amdgcn_fence(__ATOMIC_ACQUIRE, "agent");
            xb_add(&bar[XB_XGEN(x)], 1u);
            asm volatile("s_waitcnt vmcnt(0)" ::: "memory");
        } else {
            XB_SPIN(xb_ld(&bar[XB_XGEN(x)]) == gen, bar);
            __builtin_amdgcn_fence(__ATOMIC_ACQUIRE, "agent");
            asm volatile("s_waitcnt vmcnt(0)" ::: "memory");
        }
    }
    __syncthreads();
}

constexpr int NPHASE = 17;
#ifndef MK_LAUNCHES
#define MK_LAUNCHES 1
#endif
__device__ __forceinline__ Frame make_frame(int wave_s, unsigned char* lds_raw, unsigned char* ws) {
    Frame F; int t_ = fresh_tid(wave_s); int bx = blockIdx.x, G = gridDim.x; asm volatile("" : "+s"(bx), "+s"(G));
    F.lds = (LAS unsigned char*)lds_raw; F.tid = t_; F.lane = t_ & 63; F.wave = __builtin_amdgcn_readfirstlane(t_ >> 6);
    F.G = G; F.vcu = (G % 8 == 0) ? (bx % 8) * (G / 8) + bx / 8 : bx; F.ws = ws; return F;
}
#define PH_IN(k) (A.ph_lo <= (k) && (k) < A.ph_hi)
#define PH_SEAM(k) do { if (PH_IN(k) && PH_IN((k) + 1)) xcd_barrier(fresh_tid(wave_s), (unsigned*)(A.ws + WS_CTL) + CW_BAR, (volatile LAS unsigned*)((LAS unsigned char*)lds_raw + LDS_XB)); } while (0)
#ifndef FASTMASK
#define FASTMASK 15
#endif
template <int BIT, bool GATHER, class Epi, class Sched>
__device__ __forceinline__ void run_gemm(const int tid, unsigned char* lds_raw, int K, const Sched& S, const Epi& E) {
    if ((FASTMASK >> BIT) & 1) gemm_fast<Epi, Sched, GATHER>(tid, (LAS unsigned char*)lds_raw, K, S, E); else gemm_simple(tid, K, S, E);
}
#ifndef PROBE_DUP
#define PROBE_DUP 0
#endif
#define PH_REPS(k) (((PROBE_DUP >> (k)) & 1) ? 2 : 1)
#define PH_REP_BAR(rep, k) do { if ((rep) + 1 < PH_REPS(k)) xcd_barrier(fresh_tid(wave_s), (unsigned*)(A.ws + WS_CTL) + CW_BAR, (volatile LAS unsigned*)((LAS unsigned char*)lds_raw + LDS_XB)); } while (0)
#ifndef FASTATT
#define FASTATT 2
#endif
template <int LAYER>
__device__ __forceinline__ void layer_phases(const int wave_s, unsigned char* lds_raw, const Args& A) {
    unsigned char* ws = A.ws; constexpr int P = 1 + 8 * LAYER;
    if (PH_IN(P + 0)) for (int rep = 0; rep < PH_REPS(P + 0); ++rep) {
        DenseFast S{(const bf16_t*)(ws + WS_HB), (const bf16_t*)(ws + WS_WQKV) + (size_t)LAYER * 3072 * 1024, DM, T / 256, 3072 / 256, (int)gridDim.x, (int)blockIdx.x};
        EpiQKV E{(bf16_t*)(ws + WS_Q), (const float*)(ws + WS_RSTD_IN), LAYER == 0 ? (const float*)(ws + WS_ROPE) : nullptr, 0.125f * LOG2E};
        run_gemm<0, false>(fresh_tid(wave_s), lds_raw, DM, S, E);
        PH_REP_BAR(rep, P + 0);
    }
    PH_SEAM(P + 0);
    if (PH_IN(P + 1)) for (int rep = 0; rep < PH_REPS(P + 1); ++rep) {
        if (LAYER == 0) { if (FASTATT == 2) attn_diff_fast2(fresh_tid(wave_s), lds_raw, A); else if (FASTATT == 1) attn_diff_fast(fresh_tid(wave_s), lds_raw, A); else { Frame F = make_frame(wave_s, lds_raw, ws); attn_diff_simple(F, A); } }
        else { Frame F = make_frame(wave_s, lds_raw, ws); attn_sb_simple(F, A); }
        PH_REP_BAR(rep, P + 1);
    }
    if (LAYER == 0 && FASTATT == 1) {
        PH_SEAM(P + 1);
        if (PH_IN(P + 2)) { Frame F = make_frame(wave_s, lds_raw, ws); diff_combine(F, A); }
    }
    PH_SEAM(P + 2);
    if (PH_IN(P + 3)) for (int rep = 0; rep < PH_REPS(P + 3); ++rep) {
        DenseFast S{(const bf16_t*)(ws + WS_AO), (const bf16_t*)(ws + WS_WO) + (size_t)LAYER * 1024 * 1024, DM, T / 256, DM / 256, (int)gridDim.x, (int)blockIdx.x};
        EpiRes E{(bf16_t*)(ws + WS_HB)};
        run_gemm<1, false>(fresh_tid(wave_s), lds_raw, DM, S, E);
        PH_REP_BAR(rep, P + 3);
    }
    PH_SEAM(P + 3);
    if (PH_IN(P + 4)) { Frame F = make_frame(wave_s, lds_raw, ws); router_phase(F, A, LAYER); }
    PH_SEAM(P + 4);
    if (PH_IN(P + 5)) for (int rep = 0; rep < PH_REPS(P + 5); ++rep) {
        Frame F = make_frame(wave_s, lds_raw, ws);
        const LAS int* tl = moe_table(F.tid, F.lds, (const unsigned*)(ws + WS_CTL) + CW_CNT + LAYER * 32);
        MoeFast S{(const bf16_t*)(ws + WS_HB), (const bf16_t*)(ws + WS_WGU), (size_t)1024 * 1024, DM, 4, F.G, F.vcu, tl, (const int*)(ws + WS_ROWTOK), nullptr, -1, 0, 0, true};
        EpiGateUp E{(bf16_t*)(ws + WS_HID), (const float*)(ws + WS_ROWRS), tl, (unsigned*)(ws + WS_CTL) + CW_TILE + LAYER * 288};
        run_gemm<2, true>(F.tid, lds_raw, DM, S, E);
        PH_REP_BAR(rep, P + 5);
    }
    if (!FUSE_MOE) PH_SEAM(P + 5);
    if (PH_IN(P + 6)) for (int rep = 0; rep < PH_REPS(P + 6); ++rep) {
        Frame F = make_frame(wave_s, lds_raw, ws);
        const LAS int* tl = moe_table(F.tid, F.lds, (const unsigned*)(ws + WS_CTL) + CW_CNT + LAYER * 32);
        int nu = 0, dh = 0, nhi = 0;
        if (FUSE_MOE) { int ntile = 0;
#pragma unroll 1
            for (int e = 0; e < NE; ++e) ntile += __builtin_amdgcn_readfirstlane(tl[e]);
            nu = 4 * ntile; nhi = nu % F.G; const int base = nu / F.G;
            dh = nhi == 0 ? base : (4 * nu - 7 * (F.G - nhi) + 2 * F.G) / (4 * F.G); dh = dh < 0 ? 0 : (dh > base + 1 ? base + 1 : dh); }
        MoeFast S{(const bf16_t*)(ws + WS_HID), (const bf16_t*)(ws + WS_WD), (size_t)1024 * 512, FF, 4, F.G, F.vcu, tl, (const int*)(ws + WS_ROWTOK), FUSE_MOE ? (unsigned*)(ws + WS_CTL) + CW_TILE + LAYER * 288 : nullptr, FUSE_MOE ? nu : -1, dh, nhi, false};
        EpiDown E{(bf16_t*)(ws + WS_Y), (const float*)(ws + WS_ROWGATE), tl};
        run_gemm<3, false>(F.tid, lds_raw, FF, S, E);
        PH_REP_BAR(rep, P + 6);
    }
    PH_SEAM(P + 6);
    if (PH_IN(P + 7)) {
        Frame F = make_frame(wave_s, lds_raw, ws);
        if (LAYER == 0) { row_pass<1>(F, A, nullptr, nullptr); conv_moe_layer(F, A, 1); }
        else row_pass<2>(F, A, nullptr, A.out);
    }
    PH_SEAM(P + 7);
}
__global__ void __launch_bounds__(NTHREADS, 2) hybrid_fwd(Args A) {
    extern __shared__ __attribute__((aligned(16))) unsigned char lds_raw[];
    const int wave_s = __builtin_amdgcn_readfirstlane((int)threadIdx.x >> 6);
    {
        const int t0 = fresh_tid(wave_s);
        if (t0 < 2) ((volatile LAS unsigned*)((LAS unsigned char*)lds_raw + LDS_XB))[t0] = 0u;
        if (t0 == 0) (void)xb_add((unsigned*)(A.ws + WS_CTL) + CW_BAR + XB_XCNT(xb_xcc_id()), 1u);
        __syncthreads();
    }
    if (PH_IN(0)) for (int rep = 0; rep < PH_REPS(0); ++rep) { Frame F = make_frame(wave_s, lds_raw, A.ws); p0_prologue(F, A); if (rep + 1 < PH_REPS(0)) cooperative_groups::this_grid().sync(); }
    PH_SEAM(0);
    if (A.ph_lo < 0) cooperative_groups::this_grid().sync();
    layer_phases<0>(wave_s, lds_raw, A);
    layer_phases<1>(wave_s, lds_raw, A);
}

extern "C" void kernel_launch(void* const* d_in, const int* in_sizes, int n_in, void* d_out, int out_size, void* d_ws, size_t ws_size, hipStream_t stream) {
    static int grid = 0;
    if (grid == 0) {
        if (n_in != 21 || in_sizes[0] != T * DM || out_size != T * DM || ws_size < WS_END) { fprintf(stderr, "kernel_launch: unexpected shapes / workspace (%d inputs, ws %zu)\n", n_in, ws_size); grid = -1; return; }
        int dev = 0, cus = 0;
        if (hipGetDevice(&dev) != hipSuccess || hipDeviceGetAttribute(&cus, hipDeviceAttributeMultiprocessorCount, dev) != hipSuccess) { grid = -1; return; }
        if (hipFuncSetAttribute((const void*)hybrid_fwd, hipFuncAttributeMaxDynamicSharedMemorySize, LDS_BYTES) != hipSuccess) { grid = -1; return; }
        int per_cu = 0;
        if (hipOccupancyMaxActiveBlocksPerMultiprocessor(&per_cu, (const void*)hybrid_fwd, NTHREADS, LDS_BYTES) != hipSuccess || per_cu < 1) { fprintf(stderr, "kernel_launch: occupancy query says %d blocks per CU\n", per_cu); grid = -1; return; }
        grid = cus;
    }
    if (grid < 0) return;
    (void)hipMemsetAsync((char*)d_ws + WS_CTL, 0, CTL_ZERO_BYTES, stream);
    Args a{};
    a.x = (const float*)d_in[0]; a.pos = (const int*)d_in[1]; a.norm_mix = (const float*)d_in[2]; a.norm_ffn = (const float*)d_in[3]; a.norm_final = (const float*)d_in[4];
    a.a_wqkv = (const float*)d_in[5]; a.a_lq1 = (const float*)d_in[6]; a.a_lk1 = (const float*)d_in[7]; a.a_lq2 = (const float*)d_in[8]; a.a_lk2 = (const float*)d_in[9];
    a.a_subln = (const float*)d_in[10]; a.a_wo = (const float*)d_in[11]; a.b_wqkv = (const float*)d_in[12]; a.b_wo = (const float*)d_in[13];
    a.w_group = (const float*)d_in[14]; a.b_group = (const float*)d_in[15]; a.w_expert = (const float*)d_in[16]; a.b_expert = (const float*)d_in[17];
    a.w_gate = (const float*)d_in[18]; a.w_up = (const float*)d_in[19]; a.w_down = (const float*)d_in[20];
    a.out = (float*)d_out; a.ws = (unsigned char*)d_ws;
#if MK_LAUNCHES == 1
    a.ph_lo = 0; a.ph_hi = NPHASE;
    void* kargs[] = {&a};
    hipError_t e = hipLaunchCooperativeKernel((const void*)hybrid_fwd, dim3(grid), dim3(NTHREADS), kargs, LDS_BYTES, stream);
    if (e != hipSuccess) fprintf(stderr, "kernel_launch: cooperative launch failed: %s (grid %d)\n", hipGetErrorString(e), grid);
#else
    for (int ph = 0; ph < NPHASE; ++ph) {
        a.ph_lo = ph; a.ph_hi = ph + 1;
        hipLaunchKernelGGL(hybrid_fwd, dim3(grid), dim3(NTHREADS), LDS_BYTES, stream, a);
    }
#endif
}
```

```cpp
#include <hip/hip_runtime.h>
#include <hip/hip_cooperative_groups.h>
#include <cstdint>
#include <cstdio>

#define LAS __attribute__((address_space(3)))
#define GAS __attribute__((address_space(1)))
typedef unsigned short bf16_t;
typedef short bf16x8 __attribute__((ext_vector_type(8)));
typedef float f32x4 __attribute__((ext_vector_type(4)));
typedef float f32x16 __attribute__((ext_vector_type(16)));
typedef unsigned u32x4 __attribute__((ext_vector_type(4)));
typedef unsigned u32x2 __attribute__((ext_vector_type(2)));
typedef float f32x2_t __attribute__((ext_vector_type(2)));
typedef __bf16 bf16x2_t __attribute__((ext_vector_type(2)));

constexpr int DM = 1024, BATCH = 8, SEQ = 4096, T = BATCH * SEQ;
constexpr int NE = 32, EPG = 8, NG = 4, FF = 512;
constexpr float EPS = 1e-6f;
constexpr float LOG2E = 1.4426950408889634f, LN2 = 0.6931471805599453f;
constexpr int NWAVES = 8, NTHREADS = 512;
constexpr int ECAP = 32768;
constexpr int MAXROWS = 73728;

constexpr size_t MiB = 1u << 20;
constexpr size_t WS_CTL = 0, CTL_ZERO_BYTES = 32768;
constexpr size_t WS_ROPE = 1 * MiB;
constexpr size_t WS_RSTD_IN = 3 * MiB;
constexpr size_t WS_RSTD_FF = 3 * MiB + 256 * 1024;
constexpr size_t WS_TOKSLOT = 3 * MiB + 512 * 1024;
constexpr size_t WS_ROWTOK = 4 * MiB;
constexpr size_t WS_ROWGATE = 8 * MiB;
constexpr size_t WS_ROWRS = 12 * MiB;
constexpr size_t WS_WR = 16 * MiB;
constexpr size_t WS_WQKV = 17 * MiB;
constexpr size_t WS_WO = 29 * MiB;
constexpr size_t WS_WGU = 33 * MiB;
constexpr size_t WS_WD = 97 * MiB;
constexpr size_t WS_HB = 129 * MiB;
constexpr size_t WS_Q = 193 * MiB, WS_K = 257 * MiB, WS_V = 321 * MiB;
constexpr size_t WS_Y = 193 * MiB;
constexpr size_t WS_AO = 385 * MiB;
constexpr size_t WS_HID = 449 * MiB;
constexpr size_t WS_END = 521 * MiB;
static_assert(WS_Y + (size_t)MAXROWS * 1024 * 2 <= WS_AO && WS_HID + (size_t)MAXROWS * 512 * 2 <= WS_END, "ws map");
#ifndef FUSE_MOE
#define FUSE_MOE 1
#endif
constexpr int CW_GUDONE = 2700;
constexpr int CW_TILE = 2048;
constexpr int CW_CNT = 1024;

constexpr int LDS_BYTES = 147456;

__device__ __forceinline__ unsigned cvtpk(float lo, float hi) { f32x2_t v = {lo, hi}; bf16x2_t b = __builtin_convertvector(v, bf16x2_t); return __builtin_bit_cast(unsigned, b); }
__device__ __forceinline__ float bf2f(unsigned short b) { return __uint_as_float((unsigned)b << 16); }
__device__ __forceinline__ float bflo(unsigned w) { return __uint_as_float(w << 16); }
__device__ __forceinline__ float bfhi(unsigned w) { return __uint_as_float(w & 0xffff0000u); }
__device__ __forceinline__ int crow(int r, int hi) { return (r & 3) + 8 * (r >> 2) + 4 * hi; }
__device__ __forceinline__ int perm32(int rho) { const int n = rho >> 4, i = rho & 15; return 8 * (i >> 2) + 4 * n + (i & 3); }
__device__ __forceinline__ float wave_sum(float v) {
#pragma unroll
    for (int o = 1; o < 64; o <<= 1) v += __shfl_xor(v, o);
    return v;
}
__device__ __forceinline__ int lane_id() { return (int)__builtin_amdgcn_mbcnt_hi(~0u, __builtin_amdgcn_mbcnt_lo(~0u, 0u)); }
__device__ __forceinline__ int fresh_tid(int wave_s) { int z = 0; asm volatile("" : "+s"(wave_s), "+s"(z)); int t = wave_s * 64 + (int)__builtin_amdgcn_mbcnt_hi(~0u, __builtin_amdgcn_mbcnt_lo(~0u, (unsigned)z)); asm volatile("" : "+v"(t)); return t; }
#define MFMA32(a, b, c) __builtin_amdgcn_mfma_f32_32x32x16_bf16(a, b, c, 0, 0, 0)
#define MFMA16(a, b, c) __builtin_amdgcn_mfma_f32_16x16x32_bf16(a, b, c, 0, 0, 0)

struct Args {
    const float* x; const int* pos; const float* norm_mix; const float* norm_ffn; const float* norm_final;
    const float* a_wqkv; const float* a_lq1; const float* a_lk1; const float* a_lq2; const float* a_lk2; const float* a_subln; const float* a_wo;
    const float* b_wqkv; const float* b_wo;
    const float* w_group; const float* b_group; const float* w_expert; const float* b_expert; const float* w_gate; const float* w_up; const float* w_down;
    float* out; unsigned char* ws;
    int ph_lo, ph_hi;
};

struct Frame {
    LAS unsigned char* lds;
    int tid, lane, wave, vcu, G;
    unsigned char* ws;
};

__device__ __forceinline__ void transpose_item(const float* W, int N, const float* g, bf16_t* WT, int dK, int k0, int n0, int drow0, LAS float* scr, int lane) {
#pragma unroll 8
    for (int i = 0; i < 32; ++i) { const int kk = 2 * i + (lane >> 5); float v = W[(size_t)(k0 + kk) * N + n0 + (lane & 31)]; if (g) v *= g[k0 + kk]; scr[kk * 33 + (lane & 31)] = v; }
    asm volatile("s_waitcnt lgkmcnt(0)" ::: "memory");
    const int c = lane & 7;
#pragma unroll
    for (int j = 0; j < 4; ++j) { const int n = (lane >> 3) + 8 * j; const LAS float* s = scr + (8 * c) * 33 + n;
        u32x4 o; o.x = cvtpk(s[0 * 33], s[1 * 33]); o.y = cvtpk(s[2 * 33], s[3 * 33]); o.z = cvtpk(s[4 * 33], s[5 * 33]); o.w = cvtpk(s[6 * 33], s[7 * 33]);
        *(u32x4*)(WT + (size_t)(drow0 + n) * dK + k0 + 8 * c) = o; }
    asm volatile("s_waitcnt lgkmcnt(0)" ::: "memory");
}
struct ConvItem { const float* W; const float* g; bf16_t* WT; int N, dK, k0, n0, drow0; };
__device__ __forceinline__ ConvItem moe_item(const Args& A, unsigned char* ws, int layer, int it) {
    constexpr int I_G = (DM / 64) * (FF / 32), I_D = (FF / 64) * (DM / 32);
    ConvItem c; const int e = it / (2 * I_G + I_D); int r = it % (2 * I_G + I_D);
    if (r < 2 * I_G) { const int up = r / I_G; r %= I_G; const int kb = r / (FF / 32), nb = r % (FF / 32); const int n0 = nb * 32;
        c.W = (up ? A.w_up : A.w_gate) + ((size_t)layer * NE + e) * DM * FF; c.g = A.norm_ffn + layer * DM; c.WT = (bf16_t*)(ws + WS_WGU) + (size_t)e * 1024 * 1024;
        c.N = FF; c.dK = DM; c.k0 = kb * 64; c.n0 = n0; c.drow0 = (n0 >> 7) * 256 + ((n0 & 127) >> 5) * 64 + up * 32;
    } else { r -= 2 * I_G; const int kb = r / (DM / 32), nb = r % (DM / 32);
        c.W = A.w_down + ((size_t)layer * NE + e) * FF * DM; c.g = nullptr; c.WT = (bf16_t*)(ws + WS_WD) + (size_t)e * 1024 * 512;
        c.N = DM; c.dK = FF; c.k0 = kb * 64; c.n0 = nb * 32; c.drow0 = nb * 32; }
    return c;
}
constexpr int MOE_CONV_ITEMS = NE * 3 * 256;
__device__ __forceinline__ void conv_load(const ConvItem& c, f32x4 (&x)[8], int lane) {
    const float* p = c.W + (size_t)(c.k0 + (lane >> 3)) * c.N + c.n0 + (lane & 7) * 4;
#pragma unroll
    for (int i = 0; i < 8; ++i) x[i] = __builtin_nontemporal_load((const f32x4*)(p + (size_t)(8 * i) * c.N));
}
__device__ __forceinline__ void conv_store(const ConvItem& c, const f32x4 (&x)[8], LAS float* scr, int lane) {
#pragma unroll
    for (int i = 0; i < 8; ++i) { const int kk = 8 * i + (lane >> 3); const float gv = c.g ? c.g[c.k0 + kk] : 1.f; LAS float* d = scr + kk * 33 + (lane & 7) * 4;
        d[0] = x[i][0] * gv; d[1] = x[i][1] * gv; d[2] = x[i][2] * gv; d[3] = x[i][3] * gv; }
    asm volatile("s_waitcnt lgkmcnt(0)" ::: "memory");
    const int cc = lane & 7;
#pragma unroll
    for (int j = 0; j < 4; ++j) { const int n = (lane >> 3) + 8 * j; const LAS float* sp = scr + (8 * cc) * 33 + n;
        u32x4 o; o.x = cvtpk(sp[0 * 33], sp[1 * 33]); o.y = cvtpk(sp[2 * 33], sp[3 * 33]); o.z = cvtpk(sp[4 * 33], sp[5 * 33]); o.w = cvtpk(sp[6 * 33], sp[7 * 33]);
        __builtin_nontemporal_store(o, (u32x4*)(c.WT + (size_t)(c.drow0 + n) * c.dK + c.k0 + 8 * cc)); }
    asm volatile("s_waitcnt lgkmcnt(0)" ::: "memory");
}
__device__ __forceinline__ void conv_moe_range(const Args& A, unsigned char* ws, int layer, LAS float* scr, int lane, int gw, int NGW, int lo = 0, int hi = MOE_CONV_ITEMS) {
    if (lo + gw >= hi) return;
    f32x4 x[8], y[8];
    ConvItem c = moe_item(A, ws, layer, lo + gw);
    conv_load(c, x, lane);
#pragma unroll 1
    for (int it = lo + gw; it < hi; it += NGW) {
        const int nx = it + NGW; ConvItem cn = c;
        if (nx < hi) { cn = moe_item(A, ws, layer, nx); conv_load(cn, y, lane); }
        conv_store(c, x, scr, lane);
#pragma unroll
        for (int i = 0; i < 8; ++i) x[i] = y[i];
        c = cn;
    }
}
#ifndef STAG_ITEMS
#define STAG_ITEMS 4096
#endif
__device__ __forceinline__ bool stag_on(int G) { return STAG_ITEMS > 0 && (G % 16 == 0); }
__device__ __forceinline__ void conv_moe_layer(Frame& F, const Args& A, int layer) {
    conv_moe_range(A, F.ws, layer, (LAS float*)(F.lds + F.wave * 16384), F.lane, F.vcu * NWAVES + F.wave, F.G * NWAVES, stag_on(F.G) ? 2 * STAG_ITEMS : 0, MOE_CONV_ITEMS);
}

template <int MODE>
__device__ __forceinline__ void row_pass(Frame& F, const Args& A, const float* xin, float* hout) {
    const int gw = F.vcu * NWAVES + F.wave, NGW = F.G * NWAVES, lane = F.lane;
    bf16_t* HB = (bf16_t*)(F.ws + WS_HB); float* RSTD = (float*)(F.ws + WS_RSTD_IN);
    const unsigned* TS = (const unsigned*)(F.ws + WS_TOKSLOT); const bf16_t* Y = (const bf16_t*)(F.ws + WS_Y);
    const unsigned* cnt = (const unsigned*)(F.ws + WS_CTL) + CW_CNT + (MODE == 2 ? 32 : 0);
    unsigned excl = 0;
    if (MODE != 0) { const unsigned pad = lane < 32 ? ((cnt[lane & 31] + 255u) & ~255u) : 0u; unsigned incl = pad;
#pragma unroll
        for (int o = 1; o < 32; o <<= 1) { const unsigned t = __shfl_up(incl, o); if (lane >= o) incl += t; }
        excl = incl - pad; }
    f32x4 gf[4];
    if (MODE == 2) {
#pragma unroll
        for (int j = 0; j < 4; ++j) gf[j] = *(const f32x4*)(A.norm_final + 4 * lane + 256 * j);
    }
    for (int row0 = gw; row0 < T; row0 += 2 * NGW) {
        f32x4 v[2][4]; u32x2 hb[2][4]; u32x2 y[2][2][4]; bool ok[2];
#pragma unroll
        for (int q = 0; q < 2; ++q) { const int row = row0 + q * NGW; ok[q] = row < T;
            if (ok[q]) {
                if (MODE == 0) {
#pragma unroll
                    for (int j = 0; j < 4; ++j) v[q][j] = __builtin_nontemporal_load((const f32x4*)(xin + (size_t)row * DM + 4 * lane + 256 * j));
                } else {
#pragma unroll
                    for (int j = 0; j < 4; ++j) hb[q][j] = *(const u32x2*)(HB + (size_t)row * DM + 4 * lane + 256 * j);
#pragma unroll
                    for (int k = 0; k < 2; ++k) { const unsigned ts = __builtin_amdgcn_readfirstlane(TS[2 * row + k]); const int e = ts >> 16, slot = ts & 0xffff;
                        const unsigned ps = __builtin_amdgcn_readlane(excl, e);
                        const bf16_t* yr = Y + (size_t)(ps + slot) * DM;
#pragma unroll
                        for (int j = 0; j < 4; ++j) y[q][k][j] = __builtin_nontemporal_load((const u32x2*)(yr + 4 * lane + 256 * j)); }
                }
            }
        }
#pragma unroll
        for (int q = 0; q < 2; ++q) if (ok[q]) { const int row = row0 + q * NGW;
            if (MODE != 0) {
#pragma unroll
                for (int j = 0; j < 4; ++j) { const u32x2 w = hb[q][j]; v[q][j].x = bflo(w.x); v[q][j].y = bfhi(w.x); v[q][j].z = bflo(w.y); v[q][j].w = bfhi(w.y); }
#pragma unroll
                for (int k = 0; k < 2; ++k)
#pragma unroll
                    for (int j = 0; j < 4; ++j) { const u32x2 w = y[q][k][j]; v[q][j].x += bflo(w.x); v[q][j].y += bfhi(w.x); v[q][j].z += bflo(w.y); v[q][j].w += bfhi(w.y); }
            }
            float s = 0.f;
#pragma unroll
            for (int j = 0; j < 4; ++j) s += (v[q][j].x * v[q][j].x + v[q][j].y * v[q][j].y) + (v[q][j].z * v[q][j].z + v[q][j].w * v[q][j].w);
            const float rstd = __builtin_amdgcn_rsqf(wave_sum(s) * (1.f / DM) + EPS);
            if (MODE == 2) {
#pragma unroll
                for (int j = 0; j < 4; ++j) __builtin_nontemporal_store(v[q][j] * rstd * gf[j], (f32x4*)(hout + (size_t)row * DM + 4 * lane + 256 * j));
            } else {
#pragma unroll
                for (int j = 0; j < 4; ++j) { u32x2 w; w.x = cvtpk(v[q][j].x, v[q][j].y); w.y = cvtpk(v[q][j].z, v[q][j].w); *(u32x2*)(HB + (size_t)row * DM + 4 * lane + 256 * j) = w; }
                if (lane == 0) RSTD[row] = rstd;
            }
        }
    }
}

__device__ __forceinline__ void p0_prologue(Frame& F, const Args& A) {
    LAS float* scr = (LAS float*)(F.lds + F.wave * 16384);
    const int gw = F.vcu * NWAVES + F.wave, NGW = F.G * NWAVES;
    bf16_t* WQKV = (bf16_t*)(F.ws + WS_WQKV); bf16_t* WO = (bf16_t*)(F.ws + WS_WO);
    constexpr int I_QKV = (DM / 64) * (3072 / 32), I_O = (DM / 64) * (DM / 32);
    constexpr int NIT = 2 * I_QKV + 2 * I_O;
    {
        auto item = [&](int it) { ConvItem c; int r = it;
            if (r < 2 * I_QKV) { const int l = r / I_QKV; r %= I_QKV; const int kb = r / 96, nb = r % 96; c.W = l ? A.b_wqkv : A.a_wqkv; c.g = A.norm_mix + l * DM; c.WT = WQKV + (size_t)l * 3072 * 1024; c.N = 3072; c.dK = DM; c.k0 = kb * 64; c.n0 = nb * 32; c.drow0 = nb * 32; }
            else { r -= 2 * I_QKV; const int l = r / I_O; r %= I_O; const int kb = r / 32, nb = r % 32; c.W = l ? A.b_wo : A.a_wo; c.g = nullptr; c.WT = WO + (size_t)l * 1024 * 1024; c.N = DM; c.dK = DM; c.k0 = kb * 64; c.n0 = nb * 32; c.drow0 = nb * 32; }
            return c; };
        if (gw < NIT) { f32x4 xx[8], yy[8]; ConvItem c = item(gw); conv_load(c, xx, F.lane);
#pragma unroll 1
            for (int it = gw; it < NIT; it += NGW) { const int nx = it + NGW; ConvItem cn = c; if (nx < NIT) { cn = item(nx); conv_load(cn, yy, F.lane); }
                conv_store(c, xx, scr, F.lane);
#pragma unroll
                for (int i = 0; i < 8; ++i) xx[i] = yy[i];
                c = cn; } }
    }
    conv_moe_layer(F, A, 0);
    { bf16_t* WR = (bf16_t*)(F.ws + WS_WR);
      const int gt = (F.vcu * NWAVES + F.wave) * 64 + F.lane, NGT = F.G * NWAVES * 64;
      for (int i = gt; i < 2 * 64 * 1024; i += NGT) { const int l = i >> 16, j = (i >> 10) & 63, k = i & 1023;
          float w = 0.f; if (j < 32) w = A.w_expert[((size_t)l * DM + k) * NE + j]; else if (j < 36) w = A.w_group[((size_t)l * DM + k) * NG + (j - 32)];
          w *= A.norm_ffn[l * DM + k];
          const unsigned h = cvtpk(w, 0.f) & 0xffffu; const float rem = w - bf2f((unsigned short)h); const unsigned lo = cvtpk(rem, 0.f) & 0xffffu;
          WR[((size_t)(l * 2 + 0) * 64 + j) * 1024 + k] = (bf16_t)h; WR[((size_t)(l * 2 + 1) * 64 + j) * 1024 + k] = (bf16_t)lo; }
      float* RT = (float*)(F.ws + WS_ROPE);
      for (int i = gt; i < T * 8; i += NGT) { const int row = i >> 3, f = i & 7; const float invf = powf(500000.0f, -(float)f / 8.0f); const float ang = (float)A.pos[row] * invf;
          float sn, cs; sincosf(ang, &sn, &cs); RT[row * 16 + f] = cs; RT[row * 16 + 8 + f] = sn; }
    }
    row_pass<0>(F, A, A.x, nullptr);
}

struct Unit { int pm, pn, e, slot0; };
template <class Epi, class Sched>
__device__ __forceinline__ void gemm_simple(const int tid, int K, const Sched& S, const Epi& E) {
    const int wid = __builtin_amdgcn_readfirstlane(tid >> 6), lane = tid & 63, wr = wid >> 2, wc = wid & 3, fr = lane & 15, fq = lane >> 4;
    Unit u;
    for (int ui = 0; S.next(ui, u); ++ui) {
        f32x4 acc[2][2][4][2];
#pragma unroll
        for (int a = 0; a < 2; ++a)
#pragma unroll
            for (int b = 0; b < 2; ++b)
#pragma unroll
                for (int m = 0; m < 4; ++m)
#pragma unroll
                    for (int n = 0; n < 2; ++n) acc[a][b][m][n] = (f32x4){0.f, 0.f, 0.f, 0.f};
        unsigned aoff[2][4], boff[2][2];
        const char* Ab = (const char*)S.abase();
#pragma unroll
        for (int a = 0; a < 2; ++a)
#pragma unroll
            for (int m = 0; m < 4; ++m) aoff[a][m] = (unsigned)S.arow(u, a * 128 + wr * 64 + m * 16 + fr) * (unsigned)(K * 2) + fq * 16;
        const char* Bb = (const char*)S.bbase(u);
#pragma unroll
        for (int b = 0; b < 2; ++b)
#pragma unroll
            for (int n = 0; n < 2; ++n) boff[b][n] = (unsigned)(wc * 64 + b * 32 + perm32(n * 16 + fr)) * (unsigned)(K * 2) + fq * 16;
#pragma unroll 1
        for (int k0 = 0; k0 < K; k0 += 32) {
            bf16x8 af[2][4], bf[2][2];
            const char* Ak = Ab + k0 * 2; const char* Bk = Bb + k0 * 2;
#pragma unroll
            for (int a = 0; a < 2; ++a)
#pragma unroll
                for (int m = 0; m < 4; ++m) af[a][m] = *(const bf16x8*)(Ak + aoff[a][m]);
#pragma unroll
            for (int b = 0; b < 2; ++b)
#pragma unroll
                for (int n = 0; n < 2; ++n) bf[b][n] = *(const bf16x8*)(Bk + boff[b][n]);
#pragma unroll
            for (int a = 0; a < 2; ++a)
#pragma unroll
                for (int b = 0; b < 2; ++b)
#pragma unroll
                    for (int m = 0; m < 4; ++m)
#pragma unroll
                        for (int n = 0; n < 2; ++n) acc[a][b][m][n] = MFMA16(bf[b][n], af[a][m], acc[a][b][m][n]);
        }
        E(acc, u, wr, wc, fr, fq);
    }
}


constexpr int BK = 64, HALF = 128, HTB = HALF * BK * 2;
__device__ __forceinline__ int lds_byte(int r, int c) { const int q = (r >> 2) & 3, pos = ((c >> 3) & 3) ^ ((4 - q) & 3); return (r >> 3) * 1024 + (c >> 5) * 512 + (r & 7) * 64 + pos * 16 + (c & 7) * 2; }
__device__ __forceinline__ void stage_rc(int b, int& R, int& C) { const int ch = b >> 10, ks = (b >> 9) & 1, r7 = (b >> 6) & 7, pos = (b >> 4) & 3; R = ch * 8 + r7; const int q = (R >> 2) & 3; C = ks * 32 + ((pos ^ ((4 - q) & 3)) << 3); }
template <class Epi, class Sched, bool GATHER>
__device__ __forceinline__ void gemm_fast(const int tid, LAS unsigned char* lds, const int K, const Sched& S, const Epi& E) {
    const int wid = __builtin_amdgcn_readfirstlane(tid >> 6), lane = tid & 63, wr = wid >> 2, wc = wid & 3, fr = lane & 15, fq = lane >> 4;
    const int nt = K / BK;
    unsigned voffA[2], voffB[2]; int RA[2], CA[2];
#pragma unroll
    for (int i = 0; i < 2; ++i) { int R, C; stage_rc(tid * 16 + i * 8192, R, C); const int Rb = (R >> 5) * 64 + perm32(R & 31); RA[i] = R; CA[i] = C;
        voffA[i] = (unsigned)(R * K + C) * 2u; voffB[i] = (unsigned)(Rb * K + C) * 2u; }
    const size_t kstep = (size_t)(BK * 2), hstep = (size_t)HALF * K * 2, hstepB = (size_t)32 * K * 2;
    const unsigned ldsw = (unsigned)wid * 1024u;
    const int aoff = lds_byte(wr * 64 + fr, fq * 8), boff = lds_byte(wc * 32 + fr, fq * 8);
#define G_SA(b, h) (((b) * 2 + (h)) * HTB)
#define G_SB(b, h) ((4 + (b) * 2 + (h)) * HTB)
#define G_STAGE(bufoff, gbase, v0, v1) do { \
        __builtin_amdgcn_global_load_lds((const unsigned*)((const char*)(gbase) + (v0)), (LAS unsigned*)(lds + (bufoff) + ldsw), 16, 0, 0); \
        __builtin_amdgcn_global_load_lds((const unsigned*)((const char*)(gbase) + (v1)), (LAS unsigned*)(lds + (bufoff) + ldsw + 8192), 16, 0, 0); } while (0)
#define G_STAGE_B(bufoff, gbase) G_STAGE(bufoff, gbase, voffB[0], voffB[1])
#define G_STAGE_A(bufoff, X, h, koff) do { if (GATHER) { G_STAGE(bufoff, Abase + (koff), (X) ? gn[h][0] : ga[h][0], (X) ? gn[h][1] : ga[h][1]); } \
        else { G_STAGE(bufoff, ((X) ? nA : cA) + (h) * hstep + (koff), voffA[0], voffA[1]); } } while (0)
#define G_STAGE_A_RT(bufoff, L, h, koff) do { if (GATHER) { const unsigned o0_ = (L) ? gn[h][0] : ga[h][0], o1_ = (L) ? gn[h][1] : ga[h][1]; G_STAGE(bufoff, Abase + (koff), o0_, o1_); } \
        else { G_STAGE(bufoff, ((L) ? nA : cA) + (h) * hstep + (koff), voffA[0], voffA[1]); } } while (0)
#define G_LDA(dst, b, h) do { _Pragma("unroll") for (int m = 0; m < 4; ++m) _Pragma("unroll") for (int k = 0; k < 2; ++k) dst[m][k] = *(const LAS bf16x8*)(lds + G_SA(b, h) + aoff + m * 2048 + k * 512); } while (0)
#define G_LDB(dst, b, h) do { _Pragma("unroll") for (int n = 0; n < 2; ++n) _Pragma("unroll") for (int k = 0; k < 2; ++k) dst[n][k] = *(const LAS bf16x8*)(lds + G_SB(b, h) + boff + n * 2048 + k * 512); } while (0)
#define G_MMA(ai, bj, At, Bt) do { __builtin_amdgcn_s_setprio(1); _Pragma("unroll") for (int m = 0; m < 4; ++m) _Pragma("unroll") for (int n = 0; n < 2; ++n) _Pragma("unroll") for (int k = 0; k < 2; ++k) \
        acc[ai][bj][m][n] = MFMA16(Bt[n][k], At[m][k], acc[ai][bj][m][n]); __builtin_amdgcn_s_setprio(0); } while (0)
#define G_WAIT_V(n) asm volatile("s_waitcnt vmcnt(" #n ")" ::: "memory")
#define G_WAIT_L(n) asm volatile("s_waitcnt lgkmcnt(" #n ")" ::: "memory")
#define G_BAR __builtin_amdgcn_s_barrier()
#define G_SCHED __builtin_amdgcn_sched_barrier(0)
    Unit cur, nxt; int ui = 0;
    if (!S.next(0, cur)) return;
    f32x4 acc[2][2][4][2];
#pragma unroll
    for (int a = 0; a < 2; ++a)
#pragma unroll
        for (int b = 0; b < 2; ++b)
#pragma unroll
            for (int m = 0; m < 4; ++m)
#pragma unroll
                for (int n = 0; n < 2; ++n) acc[a][b][m][n] = (f32x4){0.f, 0.f, 0.f, 0.f};
    bf16x8 At[4][2], B0[2][2], B1[2][2];
    const char* const Abase = (const char*)S.abase();
    unsigned ga[2][2], gn[2][2];
    const char* cA = GATHER ? Abase : (const char*)S.a_tile(cur); const char* cB = (const char*)S.b_tile(cur);
    if (GATHER) {
#pragma unroll
        for (int h = 0; h < 2; ++h)
#pragma unroll
            for (int i = 0; i < 2; ++i) { ga[h][i] = (unsigned)S.tok(cur, h * HALF + RA[i]) * (unsigned)(K * 2) + (unsigned)CA[i] * 2u; gn[h][i] = ga[h][i]; }
    }
    const char* nA = cA; const char* nB = cB;
    float pv[8] = {0.f, 0.f, 0.f, 0.f, 0.f, 0.f, 0.f, 0.f}; if (Epi::PRE) E.pre(cur, wr, fr, pv);
    bool has_next = false; int tkr[2][2] = {{0, 0}, {0, 0}}; unsigned pw0 = 0u, pw1 = 0u;
    has_next = S.next_a(1, nxt, pw0, pw1);
    if (GATHER) {
        if (has_next) {
#pragma unroll
            for (int h = 0; h < 2; ++h)
#pragma unroll
                for (int i = 0; i < 2; ++i) tkr[h][i] = S.tok_raw(nxt, h * HALF + RA[i]); } }
    G_STAGE_B(G_SB(0, 0), cB); G_STAGE_B(G_SB(0, 1), cB + hstepB); G_STAGE_A(G_SA(0, 0), 0, 0, 0); G_STAGE_A(G_SA(0, 1), 0, 1, 0);
    if (wr == 1) G_BAR;
    G_WAIT_V(2); G_BAR;
    G_STAGE_B(G_SB(1, 0), cB + kstep); G_STAGE_A(G_SA(1, 0), 0, 0, kstep); G_STAGE_B(G_SB(1, 1), cB + hstepB + kstep);
    G_WAIT_V(6); G_BAR;
    for (;;) {
        if (has_next) S.next_b(nxt, pw0, pw1);
        nA = has_next ? (GATHER ? Abase : (const char*)S.a_tile(nxt)) : cA; nB = has_next ? (const char*)S.b_tile(nxt) : cB;
        if (GATHER && has_next) {
#pragma unroll
            for (int h = 0; h < 2; ++h)
#pragma unroll
                for (int i = 0; i < 2; ++i) gn[h][i] = (unsigned)S.tok_sel(nxt, h * HALF + RA[i], tkr[h][i]) * (unsigned)(K * 2) + (unsigned)CA[i] * 2u;
        }
        for (int t = 0; t < nt; t += 2) {
            const bool last = (t == nt - 2);
            const size_t k1 = (size_t)(t + 1) * kstep, k2 = last ? 0 : (size_t)(t + 2) * kstep, k3 = k2 + kstep;
            const char* b2 = (last ? nB : cB) + k2; const char* b3 = b2 + kstep;
            G_LDB(B0, 0, 0); G_LDB(B1, 0, 1); G_SCHED; G_LDA(At, 0, 0); G_STAGE_A(G_SA(1, 1), 0, 1, k1);
            G_WAIT_V(8); G_WAIT_L(0); G_BAR; G_MMA(0, 0, At, B0); G_MMA(0, 1, At, B1); G_BAR; G_SCHED;
            G_LDA(At, 0, 1); G_STAGE_B(G_SB(0, 0), b2); G_STAGE_B(G_SB(0, 1), b2 + hstepB); G_STAGE_A_RT(G_SA(0, 0), last, 0, k2);
            G_WAIT_V(8); G_WAIT_L(0); G_BAR; G_MMA(1, 0, At, B0); G_MMA(1, 1, At, B1); G_BAR; G_SCHED;
            G_LDB(B0, 1, 0); G_LDB(B1, 1, 1); G_SCHED; G_LDA(At, 1, 0); G_STAGE_A_RT(G_SA(0, 1), last, 1, k2);
            G_WAIT_V(8); G_WAIT_L(0); G_BAR; G_MMA(0, 0, At, B0); G_MMA(0, 1, At, B1); G_BAR; G_SCHED;
            G_LDA(At, 1, 1); G_STAGE_B(G_SB(1, 0), b3); G_STAGE_B(G_SB(1, 1), b3 + hstepB); G_STAGE_A_RT(G_SA(1, 0), last, 0, k3);
            G_WAIT_V(8); G_WAIT_L(0); G_BAR; G_MMA(1, 0, At, B0); G_MMA(1, 1, At, B1); G_BAR; G_SCHED;
        }
        Unit nn = nxt; bool has_nn = false; int tk2[2][2] = {{0, 0}, {0, 0}}; unsigned qw0 = 0u, qw1 = 0u;
        if (has_next) has_nn = S.next_a(ui + 2, nn, qw0, qw1);
        if (GATHER && has_next) {
            if (has_nn) {
#pragma unroll
                for (int h = 0; h < 2; ++h)
#pragma unroll
                    for (int i = 0; i < 2; ++i) tk2[h][i] = S.tok_raw(nn, h * HALF + RA[i]); } }
        float pvn[8] = {0.f, 0.f, 0.f, 0.f, 0.f, 0.f, 0.f, 0.f}; if (Epi::PRE && has_next) E.pre(nxt, wr, fr, pvn);
        if (wr == 0) G_BAR;
        E(acc, cur, wr, wc, fr, fq, pv);
        if (Epi::SIGNAL) { G_WAIT_V(0); G_BAR; if (tid == 0) E.signal(cur); }
        if (!has_next) break;
#pragma unroll
        for (int a = 0; a < 2; ++a)
#pragma unroll
            for (int b = 0; b < 2; ++b)
#pragma unroll
                for (int m = 0; m < 4; ++m)
#pragma unroll
                    for (int n = 0; n < 2; ++n) acc[a][b][m][n] = (f32x4){0.f, 0.f, 0.f, 0.f};
        cur = nxt; cA = nA; cB = nB; ++ui;
        if (GATHER) {
#pragma unroll
            for (int h = 0; h < 2; ++h)
#pragma unroll
                for (int i = 0; i < 2; ++i) { ga[h][i] = gn[h][i]; tkr[h][i] = tk2[h][i]; }
        }
        nxt = nn; has_next = has_nn; pw0 = qw0; pw1 = qw1;
        if (Epi::PRE) {
#pragma unroll
            for (int q = 0; q < 8; ++q) pv[q] = pvn[q]; }
        if (wr == 1) G_BAR;
    }
    G_WAIT_V(0);
    G_BAR;
#undef G_SA
#undef G_SB
#undef G_STAGE
#undef G_STAGE_B
#undef G_STAGE_A
#undef G_STAGE_A_RT
#undef G_LDA
#undef G_LDB
#undef G_MMA
#undef G_WAIT_V
#undef G_WAIT_L
#undef G_BAR
#undef G_SCHED
}

struct DenseFast {
    const bf16_t* A; const bf16_t* Bt; int K, nM, nN, G, c;
    __device__ __forceinline__ bool next(int i, Unit& u) const {
        const int nwg = nM * nN; const int L = i * G + c; if (L >= nwg) return false;
        int wgid = L; { const int q = nwg / 8, r = nwg % 8, xcd = wgid % 8, off = wgid / 8; wgid = (xcd < r ? xcd * (q + 1) : r * (q + 1) + (xcd - r) * q) + off; }
        const int nig = 8 * nN, gid = wgid / nig, fm = gid * 8, gsz = (nM - fm) < 8 ? (nM - fm) : 8;
        u.pm = fm + ((wgid % nig) % gsz); u.pn = (wgid % nig) / gsz; u.e = 0; u.slot0 = 0; return true;
    }
    __device__ __forceinline__ bool next_a(int i, Unit& u, unsigned& p0, unsigned& p1) const { p0 = 0u; p1 = 0u; return next(i, u); }
    __device__ __forceinline__ void next_b(const Unit&, unsigned, unsigned) const {}
    __device__ __forceinline__ const bf16_t* abase() const { return A; }
    __device__ __forceinline__ const bf16_t* a_tile(const Unit& u) const { return A + (size_t)(u.pm * 256) * K; }
    __device__ __forceinline__ const bf16_t* b_tile(const Unit& u) const { return Bt + (size_t)(u.pn * 256) * K; }
    __device__ __forceinline__ int tok(const Unit& u, int r) const { return u.pm * 256 + r; }
    __device__ __forceinline__ int tok_raw(const Unit& u, int r) const { return u.pm * 256 + r; }
    __device__ __forceinline__ int tok_sel(const Unit& u, int r, int raw) const { return raw; }
    __device__ __forceinline__ int arow(const Unit& u, int r) const { return u.pm * 256 + r; }
    __device__ __forceinline__ const bf16_t* bbase(const Unit& u) const { return b_tile(u); }
};
struct MoeFast {
    const bf16_t* A; const bf16_t* Bt; size_t estride; int K, nN, G, c; const LAS int* tl; const int* rowtok; unsigned* dep; int NU, dh, nhi;
    __device__ __forceinline__ bool next_a(int i, Unit& u, unsigned& p0, unsigned& p1) const {
        int L = i * G + c;
        if (NU >= 0) {
            if (i >= dh) { if (c < nhi) return false; L = dh * G + (c - nhi) + (i - dh) * (G - nhi); }
            if (L >= NU) return false;
        }
        const int gt = L / nN; u.pn = L % nN;
#pragma unroll 1
        while (ce < NE) { const int nt = __builtin_amdgcn_readfirstlane(tl[ce]); if (gt < cpm + nt) break; cpm += nt; ++ce; }
        if (ce == NE) return false;
        u.e = ce; u.slot0 = (gt - cpm) * 256; u.pm = gt;
        p0 = 0u; p1 = 0u;
        if (dep && !alld) { if (doneall) p0 = __hip_atomic_load(doneall, __ATOMIC_RELAXED, __HIP_MEMORY_SCOPE_AGENT); p1 = __hip_atomic_load(dep + u.pm, __ATOMIC_RELAXED, __HIP_MEMORY_SCOPE_AGENT); }
        return true;
    }
    __device__ __forceinline__ void next_b(const Unit& u, unsigned p0, unsigned p1) const {
        if (dep && !alld) {
            if (doneall && __builtin_amdgcn_readfirstlane((int)p0) >= G) alld = true;
            else if (__builtin_amdgcn_readfirstlane((int)p1) < 4) { unsigned sp = 0;
                while (__builtin_amdgcn_readfirstlane((int)__hip_atomic_load(dep + u.pm, __ATOMIC_RELAXED, __HIP_MEMORY_SCOPE_AGENT)) < 4) { __builtin_amdgcn_s_sleep(2); if (++sp > (1u << 22)) break; } }
        }
    }
    __device__ __forceinline__ bool next(int i, Unit& u) const { unsigned p0, p1; if (!next_a(i, u, p0, p1)) return false; next_b(u, p0, p1); return true; }
    __device__ __forceinline__ const bf16_t* abase() const { return A; }
    __device__ __forceinline__ const bf16_t* a_tile(const Unit& u) const { return A + (size_t)(u.pm * 256) * K; }
    __device__ __forceinline__ const bf16_t* b_tile(const Unit& u) const { return Bt + (size_t)u.e * estride + (size_t)(u.pn * 256) * K; }
    __device__ __forceinline__ int tok(const Unit& u, int r) const { const int slot = u.slot0 + r; const int t = rowtok[u.e * ECAP + slot]; return slot < __builtin_amdgcn_readfirstlane(tl[32 + u.e]) ? t : 0; }
    __device__ __forceinline__ int tok_raw(const Unit& u, int r) const { return rowtok[u.e * ECAP + u.slot0 + r]; }
    __device__ __forceinline__ int tok_sel(const Unit& u, int r, int raw) const { return (u.slot0 + r) < __builtin_amdgcn_readfirstlane(tl[32 + u.e]) ? raw : 0; }
    bool gather; mutable int ce = 0, cpm = 0; unsigned* doneall = nullptr; mutable bool alld = false;
    __device__ __forceinline__ int arow(const Unit& u, int r) const { return gather ? tok(u, r) : u.pm * 256 + r; }
    __device__ __forceinline__ const bf16_t* bbase(const Unit& u) const { return b_tile(u); }
};
constexpr int LDS_SBQ = 131072 + 12288;
constexpr int LDS_TL = 131072 + 4096;
__device__ __forceinline__ const LAS int* moe_table(const int tid, LAS unsigned char* lds, const unsigned* cnt) {
    LAS int* tl = (LAS int*)(lds + LDS_TL);
    if (tid < 32) { const int c = (int)cnt[tid]; tl[tid] = (c + 255) >> 8; tl[32 + tid] = c; }
    __syncthreads();
    return tl;
}

__device__ __forceinline__ void st16_sc1(void* p, const u32x4& v) { asm volatile("global_store_dwordx4 %0, %1, off sc1\n\ts_nop 1" :: "v"(p), "v"(v) : "memory"); }
struct EpiQKV {
    static constexpr bool SIGNAL = false; __device__ __forceinline__ void signal(const Unit&) const {}
    bf16_t* Q; const float* rstd; const float* rope; float qscale;
    static constexpr bool PRE = false; __device__ __forceinline__ void pre(const Unit&, int, int, float (&pv)[8]) const {}
    __device__ __forceinline__ void operator()(const f32x4 (&acc)[2][2][4][2], const Unit& u, int wr, int wc, int fr, int fq, const float (&)[8]) const { (*this)(acc, u, wr, wc, fr, fq); }
    __device__ __forceinline__ void operator()(const f32x4 (&acc)[2][2][4][2], const Unit& u, int wr, int wc, int fr, int fq) const {
        const int colt = u.pn * 256, region = colt >> 10, cbase = colt & 1023;
        bf16_t* base = Q + (size_t)region * ((WS_K - WS_Q) / 2);
        const bool dorope = (rope != nullptr) && region < 2;
        const float sc = region == 0 ? qscale : 1.f;
        const int rowb = u.pm * 256 + wr * 64 + fr;
        float rsv[8];
#pragma unroll
        for (int q = 0; q < 8; ++q) rsv[q] = rstd[rowb + (q >> 2) * 128 + (q & 3) * 16];
        f32x4 rp[2][4];
        if (dorope) {
#pragma unroll
            for (int j = 0; j < 4; ++j) rp[0][j] = *(const f32x4*)(rope + rowb * 16 + 4 * j); }
#pragma unroll
        for (int q = 0; q < 8; ++q) { const int ai = q >> 2, m = q & 3;
                const int row = rowb + ai * 128 + m * 16; const float rs = rsv[q];
                if (dorope && q + 1 < 8) { const int rown = rowb + ((q + 1) >> 2) * 128 + ((q + 1) & 3) * 16;
#pragma unroll
                    for (int j = 0; j < 4; ++j) rp[(q + 1) & 1][j] = *(const f32x4*)(rope + rown * 16 + 4 * j); }
                float cs[8], sn[8];
                if (dorope) {
#pragma unroll
                    for (int i = 0; i < 4; ++i) { cs[i] = rp[q & 1][0][i]; cs[4 + i] = rp[q & 1][1][i]; sn[i] = rp[q & 1][2][i]; sn[4 + i] = rp[q & 1][3][i]; } }
#pragma unroll
                for (int bj = 0; bj < 2; ++bj) {
                    float v[8];
#pragma unroll
                    for (int i = 0; i < 4; ++i) { v[i] = acc[ai][bj][m][0][i] * rs; v[4 + i] = acc[ai][bj][m][1][i] * rs; }
                    if (dorope && bj == 0) {
#pragma unroll
                        for (int i = 0; i < 8; ++i) { const float p = __shfl_xor(v[i], 16); const float rot = v[i] * cs[i] + (fq == 0 ? -p : p) * sn[i]; v[i] = fq < 2 ? rot : v[i]; }
                    }
                    u32x4 w; w.x = cvtpk(v[0] * sc, v[1] * sc); w.y = cvtpk(v[2] * sc, v[3] * sc); w.z = cvtpk(v[4] * sc, v[5] * sc); w.w = cvtpk(v[6] * sc, v[7] * sc);
                    *(u32x4*)(base + (size_t)row * DM + cbase + wc * 64 + bj * 32 + 8 * fq) = w;
                }
            }
    }
};
struct EpiRes {
    static constexpr bool SIGNAL = false; __device__ __forceinline__ void signal(const Unit&) const {}
    static constexpr int NST = 16;
    bf16_t* hb;
    static constexpr bool PRE = false; __device__ __forceinline__ void pre(const Unit&, int, int, float (&pv)[8]) const {}
    __device__ __forceinline__ void operator()(const f32x4 (&acc)[2][2][4][2], const Unit& u, int wr, int wc, int fr, int fq, const float (&)[8]) const { (*this)(acc, u, wr, wc, fr, fq); }
    __device__ __forceinline__ void operator()(const f32x4 (&acc)[2][2][4][2], const Unit& u, int wr, int wc, int fr, int fq) const {
        bf16_t* p0 = hb + (size_t)(u.pm * 256 + wr * 64 + fr) * DM + u.pn * 256 + wc * 64 + 8 * fq;
        u32x4 r[2][4][2];
#pragma unroll
        for (int ai = 0; ai < 2; ++ai)
#pragma unroll
            for (int m = 0; m < 4; ++m)
#pragma unroll
                for (int bj = 0; bj < 2; ++bj) r[ai][m][bj] = *(const u32x4*)(p0 + (size_t)(ai * 128 + m * 16) * DM + bj * 32);
#pragma unroll
        for (int ai = 0; ai < 2; ++ai)
#pragma unroll
            for (int m = 0; m < 4; ++m)
#pragma unroll
                for (int bj = 0; bj < 2; ++bj) { const u32x4 rr = r[ai][m][bj]; const f32x4 a0 = acc[ai][bj][m][0], a1 = acc[ai][bj][m][1];
                    u32x4 w; w.x = cvtpk(bflo(rr.x) + a0[0], bfhi(rr.x) + a0[1]); w.y = cvtpk(bflo(rr.y) + a0[2], bfhi(rr.y) + a0[3]); w.z = cvtpk(bflo(rr.z) + a1[0], bfhi(rr.z) + a1[1]); w.w = cvtpk(bflo(rr.w) + a1[2], bfhi(rr.w) + a1[3]);
                    *(u32x4*)(p0 + (size_t)(ai * 128 + m * 16) * DM + bj * 32) = w; }
    }
};
struct EpiGateUp {
    bf16_t* hid; const float* rowrs; const LAS int* tl; unsigned* done;
    static constexpr bool SIGNAL = FUSE_MOE != 0;
    __device__ __forceinline__ void signal(const Unit& u) const { (void)__hip_atomic_fetch_add(done + u.pm, 1u, __ATOMIC_RELAXED, __HIP_MEMORY_SCOPE_AGENT); }
    static constexpr bool PRE = true;
    __device__ __forceinline__ void pre(const Unit& u, int wr, int fr, float (&pv)[8]) const {
#pragma unroll
        for (int q = 0; q < 8; ++q) pv[q] = rowrs[u.e * ECAP + u.slot0 + (q >> 2) * 128 + wr * 64 + (q & 3) * 16 + fr]; }
    __device__ __forceinline__ void operator()(const f32x4 (&acc)[2][2][4][2], const Unit& u, int wr, int wc, int fr, int fq) const { float pv[8]; pre(u, wr, fr, pv); (*this)(acc, u, wr, wc, fr, fq, pv); }
    __device__ __forceinline__ void operator()(const f32x4 (&acc)[2][2][4][2], const Unit& u, int wr, int wc, int fr, int fq, const float (&rsv)[8]) const {
        const int nrow = __builtin_amdgcn_readfirstlane(tl[32 + u.e]);
#pragma unroll
        for (int ai = 0; ai < 2; ++ai)
#pragma unroll
            for (int m = 0; m < 4; ++m) {
                const int r = ai * 128 + wr * 64 + m * 16 + fr; const int slot = u.slot0 + r; const float rs = slot < nrow ? rsv[ai * 4 + m] : 0.f;
                float h[8];
#pragma unroll
                for (int i = 0; i < 8; ++i) { const float g = acc[ai][0][m][i >> 2][i & 3] * rs, up = acc[ai][1][m][i >> 2][i & 3] * rs; h[i] = g * __builtin_amdgcn_rcpf(1.f + __builtin_amdgcn_exp2f(-g * LOG2E)) * up; }
                u32x4 w; w.x = cvtpk(h[0], h[1]); w.y = cvtpk(h[2], h[3]); w.z = cvtpk(h[4], h[5]); w.w = cvtpk(h[6], h[7]);
                if (SIGNAL) st16_sc1(hid + (size_t)(u.pm * 256 + r) * FF + u.pn * 128 + wc * 32 + 8 * fq, w); else *(u32x4*)(hid + (size_t)(u.pm * 256 + r) * FF + u.pn * 128 + wc * 32 + 8 * fq) = w;
            }
    }
};
struct EpiDown {
    static constexpr bool SIGNAL = false; __device__ __forceinline__ void signal(const Unit&) const {}
    bf16_t* Y; const float* rowgate; const LAS int* tl;
    static constexpr bool PRE = true;
    __device__ __forceinline__ void pre(const Unit& u, int wr, int fr, float (&pv)[8]) const {
#pragma unroll
        for (int q = 0; q < 8; ++q) pv[q] = rowgate[u.e * ECAP + u.slot0 + (q >> 2) * 128 + wr * 64 + (q & 3) * 16 + fr]; }
    __device__ __forceinline__ void operator()(const f32x4 (&acc)[2][2][4][2], const Unit& u, int wr, int wc, int fr, int fq) const { float pv[8]; pre(u, wr, fr, pv); (*this)(acc, u, wr, wc, fr, fq, pv); }
    __device__ __forceinline__ void operator()(const f32x4 (&acc)[2][2][4][2], const Unit& u, int wr, int wc, int fr, int fq, const float (&gtv)[8]) const {
        const int nrow = __builtin_amdgcn_readfirstlane(tl[32 + u.e]);
#pragma unroll
        for (int ai = 0; ai < 2; ++ai)
#pragma unroll
            for (int m = 0; m < 4; ++m) {
                const int r = ai * 128 + wr * 64 + m * 16 + fr; const int slot = u.slot0 + r; const float gt = slot < nrow ? gtv[ai * 4 + m] : 0.f;
#pragma unroll
                for (int bj = 0; bj < 2; ++bj) { const f32x4 a0 = acc[ai][bj][m][0] * gt, a1 = acc[ai][bj][m][1] * gt;
                    u32x4 w; w.x = cvtpk(a0[0], a0[1]); w.y = cvtpk(a0[2], a0[3]); w.z = cvtpk(a1[0], a1[1]); w.w = cvtpk(a1[2], a1[3]);
                    *(u32x4*)(Y + (size_t)(u.pm * 256 + r) * DM + u.pn * 256 + wc * 64 + bj * 32 + 8 * fq) = w; }
            }
    }
};

__device__ __forceinline__ void qk_tile(f32x16& p0, f32x16& p1, const bf16_t* Kt, const bf16x8* qr, int r32, int hi) {
    p0 = (f32x16){}; p1 = (f32x16){};
    const bf16_t* kp = Kt + (size_t)r32 * DM + hi * 8; asm volatile("" : "+v"(kp));
#pragma unroll
    for (int d0 = 0; d0 < 4; ++d0) {
        const bf16x8 b0 = *(const bf16x8*)(kp + d0 * 16), b1 = *(const bf16x8*)(kp + 32 * DM + d0 * 16);
        p0 = MFMA32(b0, qr[d0], p0); p1 = MFMA32(b1, qr[d0], p1);
    }
}
typedef short v4i16_t __attribute__((ext_vector_type(4)));
typedef short s16x4 __attribute__((ext_vector_type(4)));
__device__ __forceinline__ s16x4 vtr(LAS const unsigned char* p) { return __builtin_bit_cast(s16x4, __builtin_amdgcn_ds_read_tr16_b64_v4i16((LAS v4i16_t*)p)); }
template <int ND>
__device__ __forceinline__ void pv_tile(f32x16* o, const f32x16& p0, const f32x16& p1, const bf16_t* Vt, LAS unsigned char* vs, int lane) {
    const int hi = lane >> 5;
    asm volatile("" ::: "memory");
#pragma unroll
    for (int i0 = 0; i0 < ND * 4; i0 += 4) {
        u32x4 t[4];
        const bf16_t* vp = Vt + (size_t)(lane / (ND * 4)) * DM + (lane % (ND * 4)) * 8; asm volatile("" : "+v"(vp));
#pragma unroll
        for (int i = 0; i < 4; ++i) t[i] = *(const u32x4*)(vp + (size_t)((i0 + i) * (64 / (ND * 4))) * DM);
        asm volatile("" : "+v"(t[0]), "+v"(t[1]), "+v"(t[2]), "+v"(t[3]));
#pragma unroll
        for (int i = 0; i < 4; ++i) { const int c = (i0 + i) * 64 + lane, row = c / (ND * 4), ch = c % (ND * 4); *(LAS u32x4*)(vs + (ch >> 2) * 4096 + row * 64 + (ch & 3) * 16) = t[i]; }
    }
    asm volatile("s_waitcnt lgkmcnt(0)" ::: "memory");
    u32x4 pw[4];
    pw[0] = (u32x4){cvtpk(p0[0], p0[1]), cvtpk(p0[2], p0[3]), cvtpk(p0[4], p0[5]), cvtpk(p0[6], p0[7])};
    pw[1] = (u32x4){cvtpk(p0[8], p0[9]), cvtpk(p0[10], p0[11]), cvtpk(p0[12], p0[13]), cvtpk(p0[14], p0[15])};
    pw[2] = (u32x4){cvtpk(p1[0], p1[1]), cvtpk(p1[2], p1[3]), cvtpk(p1[4], p1[5]), cvtpk(p1[6], p1[7])};
    pw[3] = (u32x4){cvtpk(p1[8], p1[9]), cvtpk(p1[10], p1[11]), cvtpk(p1[12], p1[13]), cvtpk(p1[14], p1[15])};
    LAS const unsigned char* vb = vs + ((lane >> 4) & 1) * 32 + (lane & 3) * 8 + (4 * hi + ((lane & 15) >> 2)) * 64;
#pragma unroll
    for (int d0 = 0; d0 < ND; ++d0) {
#pragma unroll
        for (int ks = 0; ks < 4; ++ks) {
            const s16x4 lo = vtr(vb + d0 * 4096 + ks * 1024), hh = vtr(vb + d0 * 4096 + ks * 1024 + 512);
            const bf16x8 vf = (bf16x8){lo[0], lo[1], lo[2], lo[3], hh[0], hh[1], hh[2], hh[3]};
            o[d0] = MFMA32(__builtin_bit_cast(bf16x8, pw[ks]), vf, o[d0]);
        }
    }
    asm volatile("s_waitcnt lgkmcnt(0)" ::: "memory");
}

__device__ __forceinline__ void diff_map(Frame& F, f32x16* o, const bf16_t* Q, const bf16_t* K, const bf16_t* V, size_t rb, int q0, int h, int mp) {
    const int lane = F.lane, r32 = lane & 31, hi = lane >> 5;
    LAS float* wsf = (LAS float*)(F.lds + 131072 + F.wave * 512);
    bf16x8 qr[4];
#pragma unroll
    for (int d0 = 0; d0 < 4; ++d0) qr[d0] = *(const bf16x8*)(Q + (rb + q0 + r32) * DM + h * 128 + mp * 64 + d0 * 16 + hi * 8);
    o[0] = (f32x16){}; o[1] = (f32x16){}; o[2] = (f32x16){}; o[3] = (f32x16){};
    float mrun = -1e30f, l = 0.f;
    const int nt = (q0 >> 6) + 1;
#pragma unroll 1
    for (int t = 0; t < nt; ++t) {
        const int key0 = t * 64; f32x16 p0, p1;
        qk_tile(p0, p1, K + (rb + key0) * DM + h * 128 + mp * 64, qr, r32, hi);
        if (t == nt - 1) { const int q = q0 + r32;
#pragma unroll
            for (int r = 0; r < 16; ++r) { const int kv = key0 + crow(r, hi); if (kv > q) p0[r] = -1e30f; if (kv + 32 > q) p1[r] = -1e30f; } }
        float mx = p0[0];
#pragma unroll
        for (int r = 1; r < 16; ++r) mx = fmaxf(mx, p0[r]);
#pragma unroll
        for (int r = 0; r < 16; ++r) mx = fmaxf(mx, p1[r]);
        mx = fmaxf(mx, __shfl_xor(mx, 32));
        const float mnew = fmaxf(mrun, mx), f = __builtin_amdgcn_exp2f(mrun - mnew); mrun = mnew;
        float rs = 0.f;
#pragma unroll
        for (int r = 0; r < 16; ++r) { p0[r] = __builtin_amdgcn_exp2f(p0[r] - mnew); p1[r] = __builtin_amdgcn_exp2f(p1[r] - mnew); rs += p0[r] + p1[r]; }
        l = l * f + rs;
        if (hi == 0) wsf[r32] = f;
        asm volatile("s_waitcnt lgkmcnt(0)" ::: "memory");
#pragma unroll
        for (int r = 0; r < 16; ++r) { const float fr_ = wsf[crow(r, hi)];
#pragma unroll
            for (int d0 = 0; d0 < 4; ++d0) o[d0][r] *= fr_; }
        asm volatile("s_waitcnt lgkmcnt(0)" ::: "memory");
        pv_tile<4>(o, p0, p1, V + (rb + key0) * DM + h * 128, F.lds + F.wave * 16384, lane);
    }
    l += __shfl_xor(l, 32);
    if (hi == 0) wsf[32 + r32] = 1.f / l;
    asm volatile("s_waitcnt lgkmcnt(0)" ::: "memory");
#pragma unroll
    for (int r = 0; r < 16; ++r) { const float rr = wsf[32 + crow(r, hi)];
#pragma unroll
        for (int d0 = 0; d0 < 4; ++d0) o[d0][r] *= rr; }
    asm volatile("s_waitcnt lgkmcnt(0)" ::: "memory");
}
__device__ __forceinline__ void attn_diff_simple(Frame& F, const Args& A) {
    const int lane = F.lane, r32 = lane & 31, hi = lane >> 5;
    const bf16_t* Q = (const bf16_t*)(F.ws + WS_Q); const bf16_t* K = (const bf16_t*)(F.ws + WS_K); const bf16_t* V = (const bf16_t*)(F.ws + WS_V); bf16_t* AO = (bf16_t*)(F.ws + WS_AO);
    LAS float* stg = (LAS float*)(F.lds + F.wave * 16384);
    const float d1 = A.a_lq1[lane] * A.a_lk1[lane], d2 = A.a_lq2[lane] * A.a_lk2[lane];
    const float lam = __expf(wave_sum(d1)) - __expf(wave_sum(d2)) + 0.2f;
    const f32x4 sl = *(const f32x4*)(A.a_subln + 4 * r32) * 0.8f;
    const int gw = F.vcu * NWAVES + F.wave, NGW = F.G * NWAVES;
#pragma unroll 1
    for (int it = gw; it < BATCH * 8 * 128; it += NGW) {
        const int bh = it & 63, b = bh >> 3, h = bh & 7; const int qi = it >> 6, i4 = qi >> 5, j = qi & 31;
        const int qb = (i4 == 0) ? 127 - j : (i4 == 1) ? j : (i4 == 2) ? 95 - j : 32 + j;
        const int q0 = qb * 32; const size_t rb = (size_t)b * SEQ;
        f32x16 o[4];
        diff_map(F, o, Q, K, V, rb, q0, h, 0);
#pragma unroll
        for (int r = 0; r < 16; ++r)
#pragma unroll
            for (int d0 = 0; d0 < 4; ++d0) stg[crow(r, hi) * 128 + d0 * 32 + r32] = o[d0][r];
        asm volatile("s_waitcnt lgkmcnt(0)" ::: "memory");
        float* park = A.out + (rb + q0 + hi) * DM + h * 128 + 4 * r32;
#pragma unroll 4
        for (int i = 0; i < 16; ++i) *(f32x4*)(park + (size_t)(2 * i) * DM) = *(const LAS f32x4*)(stg + (2 * i + hi) * 128 + 4 * r32);
        asm volatile("s_waitcnt lgkmcnt(0)" ::: "memory");
        diff_map(F, o, Q, K, V, rb, q0, h, 1);
#pragma unroll
        for (int r = 0; r < 16; ++r)
#pragma unroll
            for (int d0 = 0; d0 < 4; ++d0) stg[crow(r, hi) * 128 + d0 * 32 + r32] = o[d0][r];
        asm volatile("s_waitcnt lgkmcnt(0)" ::: "memory");
        bf16_t* ao = AO + (rb + q0 + hi) * DM + h * 128 + 4 * r32;
#pragma unroll 4
        for (int i = 0; i < 16; ++i) {
            const f32x4 o1 = *(const LAS f32x4*)(stg + (2 * i + hi) * 128 + 4 * r32), o0 = *(const f32x4*)(park + (size_t)(2 * i) * DM);
            const f32x4 d = o0 - lam * o1;
            float ss = (d[0] * d[0] + d[1] * d[1]) + (d[2] * d[2] + d[3] * d[3]);
#pragma unroll
            for (int o_ = 1; o_ < 32; o_ <<= 1) ss += __shfl_xor(ss, o_);
            const float rn = __builtin_amdgcn_rsqf(ss * (1.f / 128.f) + EPS);
            u32x2 w; w.x = cvtpk(d[0] * rn * sl[0], d[1] * rn * sl[1]); w.y = cvtpk(d[2] * rn * sl[2], d[3] * rn * sl[3]);
            *(u32x2*)(ao + (size_t)(2 * i) * DM) = w;
        }
        asm volatile("s_waitcnt lgkmcnt(0)" ::: "memory");
    }
}

__device__ __forceinline__ void sb_load_half(u32x4 (&kr)[4], u32x4 (&vr)[4], const bf16_t* Kt, const bf16_t* Vt, int lane) {
    const int r32 = lane & 31, hi = lane >> 5;
    unsigned ko = (unsigned)(r32 * DM + hi * 8) * 2u; asm volatile("" : "+v"(ko));
    const GAS char* kp = (const GAS char*)Kt + ko;
#pragma unroll
    for (int d0 = 0; d0 < 4; ++d0) kr[d0] = *(const GAS u32x4*)(kp + d0 * 32);
    unsigned vo = (unsigned)((lane >> 2) * DM + (lane & 3) * 8) * 2u; asm volatile("" : "+v"(vo));
    const GAS char* vp = (const GAS char*)Vt + vo;
#pragma unroll
    for (int db = 0; db < 2; ++db)
#pragma unroll
        for (int i = 0; i < 2; ++i) vr[db * 2 + i] = *(const GAS u32x4*)(vp + (size_t)(16 * i) * DM * 2 + db * 64);
}
__device__ __forceinline__ void attn_sb_simple(Frame& F, const Args& A) {
    const int lane = F.lane, r32 = lane & 31, hi = lane >> 5;
    const bf16_t* Q = (const bf16_t*)(F.ws + WS_Q); const bf16_t* K = (const bf16_t*)(F.ws + WS_K); const bf16_t* V = (const bf16_t*)(F.ws + WS_V); bf16_t* AO = (bf16_t*)(F.ws + WS_AO);
    LAS unsigned char* vs = F.lds + F.wave * 16384;
    const int gw = F.vcu * NWAVES + F.wave, NGW = F.G * NWAVES;
    LAS unsigned* tq = (LAS unsigned*)(F.lds + LDS_SBQ);
    if (F.tid == 0) *tq = NWAVES;
    __syncthreads();
    constexpr int SB_UNITS = BATCH * 16 * 128;
    auto draw = [&]() -> int {
        for (;;) { unsigned tk = 0; if (lane == 0) tk = __hip_atomic_fetch_add(tq, 1u, __ATOMIC_RELAXED, __HIP_MEMORY_SCOPE_WORKGROUP);
            const int k = (int)__builtin_amdgcn_readfirstlane(tk); if ((k / NWAVES) * NGW >= SB_UNITS) return -1;
            const int it_ = F.vcu * NWAVES + (k & (NWAVES - 1)) + (k / NWAVES) * NGW; if (it_ < SB_UNITS) return it_; } };
    u32x4 kr[4], vr[4]; bf16x8 qr[4];
    auto prefetch = [&](int it_) { const int r_ = it_ & 2047, b_ = r_ >> 8, h_ = r_ & 15, qb_ = 127 - 16 * (it_ >> 11) - ((r_ & 255) >> 4); const size_t rb_ = (size_t)b_ * SEQ;
        sb_load_half(kr, vr, K + (rb_ + qb_ * 32) * DM + h_ * 64, V + (rb_ + qb_ * 32) * DM + h_ * 64, lane);
#pragma unroll
        for (int d0 = 0; d0 < 4; ++d0) qr[d0] = *(const bf16x8*)(Q + (rb_ + qb_ * 32 + r32) * DM + h_ * 64 + d0 * 16 + hi * 8); };
    int it = F.vcu * NWAVES + F.wave; if (it >= SB_UNITS) it = draw();
    if (it >= 0) prefetch(it);
#pragma unroll 1
    while (it >= 0) {
        const int itn = draw();
        {
        const int r_ = it & 2047, b = r_ >> 8, h = r_ & 15; const int qb = 127 - 16 * (it >> 11) - ((r_ & 255) >> 4);
        const int q0 = qb * 32; const size_t rb = (size_t)b * SEQ;
        int u = qb;
        f32x16 o[2]; o[0] = (f32x16){}; o[1] = (f32x16){};
        float R = 1.f;
#pragma unroll 1
        for (; u >= 0; --u) {
            f32x16 p = (f32x16){};
#pragma unroll
            for (int d0 = 0; d0 < 4; ++d0) p = MFMA32(__builtin_bit_cast(bf16x8, kr[d0]), qr[d0], p);
            { LAS u32x4* vw = (LAS u32x4*)vs + lane;
#pragma unroll
              for (int j = 0; j < 4; ++j) vw[j * 64] = vr[j]; }
            if (u > 0) sb_load_half(kr, vr, K + (rb + (u - 1) * 32) * DM + h * 64, V + (rb + (u - 1) * 32) * DM + h * 64, lane);
            f32x16 bt, m;
#pragma unroll
            for (int r = 0; r < 16; ++r) { const float e = __builtin_amdgcn_exp2f(p[r]); const float mm = __builtin_amdgcn_rcpf(1.f + e); m[r] = mm; bt[r] = 1.f - mm; }
            if (u == qb) {
#pragma unroll
                for (int r = 0; r < 16; ++r) if (!(crow(r, hi) < r32)) { bt[r] = 0.f; m[r] = 1.f; }
                asm volatile("" : "+v"(bt), "+v"(m));
            }
            float gp[4], og[4];
#pragma unroll
            for (int i = 0; i < 4; ++i) gp[i] = (m[4 * i] * m[4 * i + 1]) * (m[4 * i + 2] * m[4 * i + 3]);
#pragma unroll
            for (int i = 0; i < 4; ++i) og[i] = __shfl_xor(gp[i], 32);
            float tb[4]; float run = 1.f;
#pragma unroll
            for (int i = 3; i >= 0; --i) { tb[i] = R * run * (hi == 0 ? og[i] : 1.f); run *= gp[i] * og[i]; }
#pragma unroll
            for (int i = 0; i < 4; ++i) { const float s3 = tb[i], s2 = s3 * m[4 * i + 3], s1 = s2 * m[4 * i + 2], s0 = s1 * m[4 * i + 1];
                bt[4 * i + 3] *= s3; bt[4 * i + 2] *= s2; bt[4 * i + 1] *= s1; bt[4 * i] *= s0; }
            R *= run;
            { u32x4 pw[2];
              pw[0] = (u32x4){cvtpk(bt[0], bt[1]), cvtpk(bt[2], bt[3]), cvtpk(bt[4], bt[5]), cvtpk(bt[6], bt[7])};
              pw[1] = (u32x4){cvtpk(bt[8], bt[9]), cvtpk(bt[10], bt[11]), cvtpk(bt[12], bt[13]), cvtpk(bt[14], bt[15])};
              LAS const unsigned char* vb = vs + ((lane >> 4) & 1) * 32 + (lane & 3) * 8 + (4 * hi + ((lane & 15) >> 2)) * 64;
#pragma unroll
              for (int d0 = 0; d0 < 2; ++d0)
#pragma unroll
                  for (int ks = 0; ks < 2; ++ks) { const s16x4 lo = vtr(vb + d0 * 2048 + ks * 1024), hh = vtr(vb + d0 * 2048 + ks * 1024 + 512);
                      const bf16x8 vf = (bf16x8){lo[0], lo[1], lo[2], lo[3], hh[0], hh[1], hh[2], hh[3]};
                      o[d0] = MFMA32(__builtin_bit_cast(bf16x8, pw[ks]), vf, o[d0]); }
              asm volatile("s_waitcnt lgkmcnt(0)" ::: "memory"); }
            if (__all(R == 0.f)) break;
        }
        if (itn >= 0) prefetch(itn);
        { LAS float* stg = (LAS float*)(vs + 8192);
#pragma unroll
          for (int r = 0; r < 16; ++r)
#pragma unroll
              for (int d0 = 0; d0 < 2; ++d0) stg[crow(r, hi) * 64 + d0 * 32 + r32] = o[d0][r];
          asm volatile("s_waitcnt lgkmcnt(0)" ::: "memory");
          bf16_t* ao = AO + (rb + q0 + (lane >> 4)) * DM + h * 64 + 4 * (lane & 15);
#pragma unroll 4
          for (int i = 0; i < 8; ++i) { const f32x4 v = *(const LAS f32x4*)(stg + (4 * i + (lane >> 4)) * 64 + 4 * (lane & 15)); u32x2 w; w.x = cvtpk(v[0], v[1]); w.y = cvtpk(v[2], v[3]); *(u32x2*)(ao + (size_t)(4 * i) * DM) = w; }
          asm volatile("s_waitcnt lgkmcnt(0)" ::: "memory"); }
        }
        it = itn;
    }
    __syncthreads();
}

#include <hip/hip_bf16.h>
#include <cmath>
namespace attn_body {
using bf16=__hip_bfloat16;
using bf16x8=__attribute__((ext_vector_type(8)))short;
using s16x4=__attribute__((ext_vector_type(4)))short;
using f32x16=__attribute__((ext_vector_type(16)))float;
using u32x4=__attribute__((ext_vector_type(4)))unsigned;
constexpr int BATCH=8,NHEAD=16,SEQ=4096,D=64,DM=NHEAD*D;
constexpr int NW=8,QBLK=32,QB=QBLK*NW,KVBLK=64,NQB=SEQ/QB;
constexpr int ATTN_PITCH=DM, ATTN_UNIT_ROWS=QB;
__device__ __forceinline__ int crow(int r,int hi){return (r&3)+8*(r>>2)+4*hi;}
#define SBAR() __builtin_amdgcn_sched_barrier(0)
__device__ __forceinline__ void cmask(f32x16&p0,f32x16&p1,int jb,int qrel,int hi){
  const float NEG=-INFINITY; int kb=64*jb+4*hi;
  #pragma unroll
  for(int r=0;r<16;++r){int kv=kb+(r&3)+8*(r>>2); if(kv>qrel)p0[r]=NEG; if(kv+32>qrel)p1[r]=NEG;}
}

constexpr int NSLOT=3, SLOTB=8192;
constexpr int LDS_K=0, LDS_V=NSLOT*SLOTB, LDS_WS=2*NSLOT*SLOTB, LDS_OST=LDS_WS+NW*64*4, LDS_BYTES=LDS_OST+NW*4096;
constexpr float C2=0.125f*1.4426950408889634f;
__device__ __forceinline__ void glds16(const void*sbase,unsigned voff,unsigned lds_dst){unsigned keep;
  asm volatile("s_nop 4\n\ts_mov_b32 %0, m0\n\ts_mov_b32 m0, %3\n\ts_nop 0\n\tglobal_load_lds_dwordx4 %1, %2\n\ts_mov_b32 m0, %0":"=&s"(keep):"v"(voff),"s"(sbase),"s"(lds_dst):"memory");}
__device__ __forceinline__ float max3f(float a,float b,float c){float r;asm("v_max3_f32 %0, %1, %2, %3":"=v"(r):"v"(a),"v"(b),"v"(c));return r;}
__device__ __forceinline__ float max2f(float a,float b){float r;asm("v_max_f32_e32 %0, %1, %2":"=v"(r):"v"(a),"v"(b));return r;}
__device__ __forceinline__ float fadd_s(float a,float b){float r;asm("v_add_f32_e32 %0, %1, %2":"=v"(r):"v"(a),"v"(b));return r;}
__device__ __forceinline__ float fsub_s(float a,float b){float r;asm("v_sub_f32_e32 %0, %1, %2":"=v"(r):"v"(a),"v"(b));return r;}
typedef float f32x2_t __attribute__((ext_vector_type(2))); typedef __bf16 bf16x2_t __attribute__((ext_vector_type(2)));
__device__ __forceinline__ unsigned cvtpk_s(float lo,float hi){f32x2_t v={lo,hi};bf16x2_t b=__builtin_convertvector(v,bf16x2_t);return __builtin_bit_cast(unsigned,b);}
#define WAIT_BAR(N) asm volatile("s_waitcnt vmcnt(" #N ") lgkmcnt(0)\n\ts_barrier":::"memory")

__device__ __forceinline__ void qkt(f32x16&p0,f32x16&p1,const char*Kslot,const bf16x8*qr,const f32x16&negm,int r32,int hi){
  const char*kb=Kslot+hi*1024+r32*16;
  #pragma unroll
  for(int d0=0;d0<4;++d0){
    const bf16x8 b0=*reinterpret_cast<const bf16x8*>(kb+d0*2048);
    const bf16x8 b1=*reinterpret_cast<const bf16x8*>(kb+d0*2048+512);
    if(d0==0){p0=__builtin_amdgcn_mfma_f32_32x32x16_bf16(b0,qr[0],negm,0,0,0);p1=__builtin_amdgcn_mfma_f32_32x32x16_bf16(b1,qr[0],negm,0,0,0);}
    else{p0=__builtin_amdgcn_mfma_f32_32x32x16_bf16(b0,qr[d0],p0,0,0,0);p1=__builtin_amdgcn_mfma_f32_32x32x16_bf16(b1,qr[d0],p1,0,0,0);}}
}
typedef __attribute__((address_space(3))) const char* lds_cptr;
typedef short v4i16_t __attribute__((ext_vector_type(4)));
__device__ __forceinline__ void kload8(bf16x8*kf,lds_cptr kp){
  kf[0]=*(const __attribute__((address_space(3))) bf16x8*)(kp);      kf[1]=*(const __attribute__((address_space(3))) bf16x8*)(kp+512);
  kf[2]=*(const __attribute__((address_space(3))) bf16x8*)(kp+2048); kf[3]=*(const __attribute__((address_space(3))) bf16x8*)(kp+2560);
  kf[4]=*(const __attribute__((address_space(3))) bf16x8*)(kp+4096); kf[5]=*(const __attribute__((address_space(3))) bf16x8*)(kp+4608);
  kf[6]=*(const __attribute__((address_space(3))) bf16x8*)(kp+6144); kf[7]=*(const __attribute__((address_space(3))) bf16x8*)(kp+6656);
}
__device__ __forceinline__ void kload2(bf16x8*kf,lds_cptr kp,int j){ kf[2*j]=*(const __attribute__((address_space(3))) bf16x8*)(kp+j*2048); kf[2*j+1]=*(const __attribute__((address_space(3))) bf16x8*)(kp+j*2048+512); }
__device__ __forceinline__ s16x4 vtr(lds_cptr p){ return __builtin_bit_cast(s16x4,__builtin_amdgcn_ds_read_tr16_b64_v4i16((__attribute__((address_space(3))) v4i16_t*)p)); }
__device__ __forceinline__ float rowmax(const f32x16&p0,const f32x16&p1){
  float a=max3f(p0[0],p0[1],p1[0]),b=max3f(p0[2],p0[3],p1[1]);a=max3f(a,p1[2],p1[3]);
  #pragma unroll
  for(int r=4;r<16;r+=4){a=max3f(a,p0[r],p0[r+1]);b=max3f(b,p0[r+2],p0[r+3]);a=max3f(a,p1[r],p1[r+1]);b=max3f(b,p1[r+2],p1[r+3]);}
  const float m=max2f(a,b);
  auto rr=__builtin_amdgcn_permlane32_swap(__float_as_uint(m),__float_as_uint(m),false,false);
  return max2f(__uint_as_float(rr[0]),__uint_as_float(rr[1]));
}
__device__ __forceinline__ void pv(f32x16*o,int vb,bf16x8 pa0,bf16x8 pa1,bf16x8 pa2,bf16x8 pa3){
  #pragma unroll
  for(int d0=0;d0<2;++d0){s16x4 lo[4],hi[4];
    #pragma unroll
    for(int ks=0;ks<4;++ks){
      asm volatile("ds_read_b64_tr_b16 %0,%1 offset:%c2":"=&v"(lo[ks]):"v"(vb),"i"(d0*4096+ks*1024):"memory");
      asm volatile("ds_read_b64_tr_b16 %0,%1 offset:%c2":"=&v"(hi[ks]):"v"(vb),"i"(d0*4096+ks*1024+512):"memory");}
    asm volatile("s_waitcnt lgkmcnt(0)":::"memory");SBAR();
    #define PK(k) (bf16x8){lo[k][0],lo[k][1],lo[k][2],lo[k][3],hi[k][0],hi[k][1],hi[k][2],hi[k][3]}
    o[d0]=__builtin_amdgcn_mfma_f32_32x32x16_bf16(pa0,PK(0),o[d0],0,0,0);
    o[d0]=__builtin_amdgcn_mfma_f32_32x32x16_bf16(pa1,PK(1),o[d0],0,0,0);
    o[d0]=__builtin_amdgcn_mfma_f32_32x32x16_bf16(pa2,PK(2),o[d0],0,0,0);
    o[d0]=__builtin_amdgcn_mfma_f32_32x32x16_bf16(pa3,PK(3),o[d0],0,0,0);
    #undef PK
  }
}

#ifndef ATTN_STORE16
#define ATTN_STORE16(p,v) (*(u32x4*)(p)=(v))
#endif
template<int THRL> __device__ __forceinline__ void attn_unit(int tid,int b,int h,int hv,int qb,const bf16*Q,const bf16*__restrict__ K,const bf16*__restrict__ V,bf16*O,char*shm){
  const int lane=tid&63,r32=lane&31,hi=lane>>5; const int wid=__builtin_amdgcn_readfirstlane(tid>>6);
  const long rowbase=(long)b*SEQ; const int q0=qb*QB;
  const bf16*Qw=Q+(rowbase+q0+wid*QBLK)*DM+h*D;
  const bf16*Kh=K+rowbase*DM+h*D,*Vh=V+rowbase*DM+hv*D;
  const unsigned lds0=(unsigned)(uintptr_t)shm;
  float*wsf=(float*)(shm+LDS_WS)+wid*64;
  const unsigned ksrc=(unsigned)(lane*DM+wid*8)*2u;
  const unsigned vsrc=(unsigned)((16*(wid&3)+(lane>>2))*DM+(wid>>2)*32+(lane&3)*8)*2u;
  const unsigned kdst=lds0+LDS_K+wid*1024, vdst=lds0+LDS_V+wid*1024;
  #define DMA_K(t,slot) glds16(Kh+(long)(t)*KVBLK*DM,ksrc,(unsigned)__builtin_amdgcn_readfirstlane(kdst+(slot)))
  #define DMA_V(t,slot) glds16(Vh+(long)(t)*KVBLK*DM,vsrc,(unsigned)__builtin_amdgcn_readfirstlane(vdst+(slot)))
  const int vb0=(int)(lds0+LDS_V)+((lane>>4)&1)*32+(lane&3)*8+(4*hi+((lane&15)>>2))*64;
  const char*Kbase=shm+LDS_K; bf16x8 kf[8];
  const lds_cptr shm3=(lds_cptr)shm; const lds_cptr kp0=shm3+LDS_K+hi*1024+r32*16; const lds_cptr vp0=shm3+LDS_V+((lane>>4)&1)*32+(lane&3)*8+(4*hi+((lane&15)>>2))*64;
  const int NT=(q0+QB)/KVBLK;
  DMA_K(0,0);DMA_V(0,0);DMA_K(1,SLOTB);
  bf16x8 qr[4];
  #pragma unroll
  for(int d0=0;d0<4;++d0)qr[d0]=*reinterpret_cast<const bf16x8*>(&Qw[(long)r32*DM+d0*16+hi*8]);
  float mhat=0.f,l_reg=0.f;f32x16 o[2];o[0]=f32x16{};o[1]=f32x16{};float z_=0.f;asm volatile("":"+v"(z_)); f32x16 negm; _Pragma("unroll") for(int r=0;r<16;++r)negm[r]=z_; asm volatile("":"+v"(negm));
  const int qrel=wid*QBLK+r32;
  #define CMASK(P0,P1,t) do{int jb_=(t)-(NT-4); if(jb_>=0)cmask(P0,P1,jb_,qrel,hi);}while(0)
  bool resc=false;
  #define START(P0,P1) do{ const float rm=rowmax(P0,P1); resc=false; \
    { const float dl=rm; mhat=fadd_s(mhat,dl); \
      _Pragma("unroll") for(int r=0;r<16;++r){P0[r]=fsub_s(P0[r],dl);P1[r]=fsub_s(P1[r],dl);} \
      _Pragma("unroll") for(int r=0;r<16;++r)negm[r]=-mhat; asm volatile("":"+v"(negm)); } \
    _Pragma("unroll") for(int r=0;r<16;++r)P0[r]=__builtin_amdgcn_exp2f(P0[r]); }while(0)
  #define RESC() do{ if(resc){ asm volatile("s_waitcnt lgkmcnt(0)":::"memory"); \
      _Pragma("unroll") for(int d_=0;d_<2;++d_) _Pragma("unroll") for(int r=0;r<16;++r)o[d_][r]*=wsf[crow(r,hi)]; } }while(0)
  f32x16 pA0,pA1,pB0,pB1;
  int sl_prev=0,sl_cur=0,sl_next=SLOTB;
  #define ROT() do{sl_prev=sl_cur;sl_cur=sl_next;sl_next=(sl_next==(NSLOT-1)*SLOTB)?0:sl_next+SLOTB;}while(0)
  DMA_K(2,2*SLOTB);
  WAIT_BAR(3);
  qkt(pA0,pA1,Kbase,qr,negm,r32,hi);asm volatile("s_nop 15\n\ts_nop 7":"+v"(pA0),"+v"(pA1));CMASK(pA0,pA1,0);
  START(pA0,pA1);
  _Pragma("unroll") for(int r=0;r<16;++r)pA1[r]=__builtin_amdgcn_exp2f(pA1[r]);
  WAIT_BAR(0);
  DMA_K(3,0);DMA_V(1,SLOTB);
  ROT();
  kload8(kf,kp0+sl_cur);
  WAIT_BAR(2);
  s16x4 vlo[8],vhi[8]; u32x4 pw0,pw1,pw2,pw3;
  #define PKW(P,B) cvtpk_s(P[B],P[B+1])
  #define PAF(k) __builtin_bit_cast(bf16x8,pw##k)
  #define VFR(i) (bf16x8){vlo[i][0],vlo[i][1],vlo[i][2],vlo[i][3],vhi[i][0],vhi[i][1],vhi[i][2],vhi[i][3]}
  #define PIN(x) asm volatile("":"+v"(x))
  #define MX3(a,b,c) __builtin_fmaxf(__builtin_fmaxf((a),(b)),(c))
  #define GAPA(MF,A0,A1,A2,A3,W0,W1,PW) do{ MF; sacc+=A0; sacc+=A1; sacc+=A2; sacc+=A3; PIN(sacc); W0; W1; PIN(PW); SBAR(); }while(0)
  #define EX(v) __builtin_amdgcn_exp2f(v)
  #define GAPB(MF,X,B) do{ MF; X[B]=EX(X[B]); X[B+1]=EX(X[B+1]); X[B+2]=EX(X[B+2]); X[B+3]=EX(X[B+3]); PIN(X); SBAR(); }while(0)
  #define VRD(i) do{ vlo[i]=vtr(vp_+(((i)>>2)*4096+((i)&3)*1024)); vhi[i]=vtr(vp_+(((i)>>2)*4096+((i)&3)*1024+512)); }while(0)
  #define KRD(G,j) do{ if(G){ kload2(kf,kp0+sl_next,j); SBAR(); } }while(0)
  #define STEP(C0,C1,P0,P1,t,GK,GV,GL) do{ SBAR(); \
    const lds_cptr vp_=vp0+sl_prev; \
    VRD(0); SBAR(); float sacc=(P0[0]+P0[1]); \
    GAPA(C0=__builtin_amdgcn_mfma_f32_32x32x16_bf16(kf[0],qr[0],negm,0,0,0), P0[2],P0[3],P0[4],P0[5],     pw0[0]=PKW(P0,0), pw0[1]=PKW(P0,2), pw0); \
    VRD(4); SBAR(); GAPA(C1=__builtin_amdgcn_mfma_f32_32x32x16_bf16(kf[1],qr[0],negm,0,0,0), P0[6],P0[7],P0[8],P0[9],     pw0[2]=PKW(P0,4), pw0[3]=PKW(P0,6), pw0); \
    VRD(1); SBAR(); GAPA(C0=__builtin_amdgcn_mfma_f32_32x32x16_bf16(kf[2],qr[1],C0,0,0,0),   P0[10],P0[11],P0[12],P0[13], pw1[0]=PKW(P0,8), pw1[1]=PKW(P0,10), pw1); \
    VRD(5); SBAR(); GAPA(C1=__builtin_amdgcn_mfma_f32_32x32x16_bf16(kf[3],qr[1],C1,0,0,0),   P0[14],P0[15],P1[0],P1[1],   pw1[2]=PKW(P0,12),pw1[3]=PKW(P0,14), pw1); \
    VRD(2); SBAR(); GAPA(C0=__builtin_amdgcn_mfma_f32_32x32x16_bf16(kf[4],qr[2],C0,0,0,0),   P1[2],P1[3],P1[4],P1[5],     pw2[0]=PKW(P1,0), pw2[1]=PKW(P1,2), pw2); \
    VRD(6); SBAR(); GAPA(C1=__builtin_amdgcn_mfma_f32_32x32x16_bf16(kf[5],qr[2],C1,0,0,0),   P1[6],P1[7],P1[8],P1[9],     pw2[2]=PKW(P1,4), pw2[3]=PKW(P1,6), pw2); \
    VRD(3); SBAR(); GAPA(C0=__builtin_amdgcn_mfma_f32_32x32x16_bf16(kf[6],qr[3],C0,0,0,0),   P1[10],P1[11],P1[12],P1[13], pw3[0]=PKW(P1,8), pw3[1]=PKW(P1,10), pw3); \
    VRD(7); SBAR(); GAPA(C1=__builtin_amdgcn_mfma_f32_32x32x16_bf16(kf[7],qr[3],C1,0,0,0),   P1[14],P1[15],0.f,0.f,       pw3[2]=PKW(P1,12),pw3[3]=PKW(P1,14), pw3); \
    l_reg+=sacc; \
    if(GK){DMA_K((t)+3,sl_cur);} if(GV){DMA_V((t)+1,sl_next);} \
    CMASK(C0,C1,t); \
    { float a=MX3(C0[0],C0[1],C1[0]),b=MX3(C0[2],C0[3],C1[1]); a=MX3(a,C1[2],C1[3]); \
      _Pragma("unroll") for(int r=4;r<16;r+=4){a=MX3(a,C0[r],C0[r+1]);b=MX3(b,C0[r+2],C0[r+3]);a=MX3(a,C1[r],C1[r+1]);b=MX3(b,C1[r+2],C1[r+3]);} \
      float rm=__builtin_fmaxf(a,b); { auto rr=__builtin_amdgcn_permlane32_swap(__float_as_uint(rm),__float_as_uint(rm),false,false); rm=__builtin_fmaxf(__uint_as_float(rr[0]),__uint_as_float(rr[1])); } \
      resc=false; \
      if(__builtin_expect(__any(rm>(float)THRL),0)){ const float dl=__builtin_fmaxf(rm,0.f); mhat+=dl; \
        _Pragma("unroll") for(int r=0;r<16;++r){C0[r]-=dl;C1[r]-=dl;} \
        _Pragma("unroll") for(int r=0;r<16;++r)negm[r]=-mhat; asm volatile("":"+v"(negm)); \
        const float f=__builtin_amdgcn_exp2f(-dl); l_reg*=f; if(hi==0)wsf[r32]=f; resc=true; } } \
    SBAR(); \
    GAPB(o[0]=__builtin_amdgcn_mfma_f32_32x32x16_bf16(PAF(0),VFR(0),o[0],0,0,0), C0,0); \
    GAPB(o[1]=__builtin_amdgcn_mfma_f32_32x32x16_bf16(PAF(0),VFR(4),o[1],0,0,0), C0,4); \
    KRD(GL,0); GAPB(o[0]=__builtin_amdgcn_mfma_f32_32x32x16_bf16(PAF(1),VFR(1),o[0],0,0,0), C0,8); \
    KRD(GL,1); GAPB(o[1]=__builtin_amdgcn_mfma_f32_32x32x16_bf16(PAF(1),VFR(5),o[1],0,0,0), C0,12); \
    KRD(GL,2); GAPB(o[0]=__builtin_amdgcn_mfma_f32_32x32x16_bf16(PAF(2),VFR(2),o[0],0,0,0), C1,0); \
    KRD(GL,3); GAPB(o[1]=__builtin_amdgcn_mfma_f32_32x32x16_bf16(PAF(2),VFR(6),o[1],0,0,0), C1,4); \
    GAPB(o[0]=__builtin_amdgcn_mfma_f32_32x32x16_bf16(PAF(3),VFR(3),o[0],0,0,0), C1,8); \
    GAPB(o[1]=__builtin_amdgcn_mfma_f32_32x32x16_bf16(PAF(3),VFR(7),o[1],0,0,0), C1,12); \
    }while(0)
  int t=1;
  #undef CMASK
  #define CMASK(P0,P1,t) do{}while(0)
  for(;t+5<NT;t+=2){
    STEP(pB0,pB1,pA0,pA1,t,true,true,true);     WAIT_BAR(2); RESC(); ROT();
    STEP(pA0,pA1,pB0,pB1,t+1,true,true,true);   WAIT_BAR(2); RESC(); ROT();
  }
  #undef CMASK
  #define CMASK(P0,P1,t) do{int jb_=(t)-(NT-4); if(jb_>=0)cmask(P0,P1,jb_,qrel,hi);}while(0)
  #define ENDW(tt) do{ if((tt)+3<NT){WAIT_BAR(2);} else if((tt)+2<NT){WAIT_BAR(1);} else {WAIT_BAR(0);} }while(0)
  for(;t+1<NT;t+=2){
    STEP(pB0,pB1,pA0,pA1,t,(t+3<NT),(t+1<NT),(t+1<NT));       ENDW(t);   RESC(); ROT();
    STEP(pA0,pA1,pB0,pB1,t+1,(t+4<NT),(t+2<NT),(t+2<NT));     ENDW(t+1); RESC(); ROT();
  }
  STEP(pB0,pB1,pA0,pA1,NT-1,false,false,false); RESC();
  { float sacc=pB0[0]+pB0[1]; _Pragma("unroll") for(int r=2;r<16;++r)sacc+=pB0[r]; _Pragma("unroll") for(int r=0;r<16;++r)sacc+=pB1[r]; l_reg+=sacc;
    pw0=(u32x4){PKW(pB0,0),PKW(pB0,2),PKW(pB0,4),PKW(pB0,6)};pw1=(u32x4){PKW(pB0,8),PKW(pB0,10),PKW(pB0,12),PKW(pB0,14)};pw2=(u32x4){PKW(pB1,0),PKW(pB1,2),PKW(pB1,4),PKW(pB1,6)};pw3=(u32x4){PKW(pB1,8),PKW(pB1,10),PKW(pB1,12),PKW(pB1,14)};
    SBAR(); pv(o,vb0+sl_cur,PAF(0),PAF(1),PAF(2),PAF(3)); }
  #undef PKW
  #undef PAF
  #undef VFR
  #undef PIN
  #undef MX3
  #undef GAPA
  #undef GAPB
  #undef EX
  #undef VRD
  #undef KRD
  #undef STEP
  #undef ENDW
  {auto rr=__builtin_amdgcn_permlane32_swap(__float_as_uint(l_reg),__float_as_uint(l_reg),false,false);l_reg=__uint_as_float(rr[0])+__uint_as_float(rr[1]);}
  if(hi==0)wsf[32+r32]=l_reg;asm volatile("s_waitcnt lgkmcnt(0)":::"memory");
  float rli[16];
  #pragma unroll
  for(int r=0;r<16;++r)rli[r]=__builtin_amdgcn_rcpf(wsf[32+crow(r,hi)]);
  bf16*Ow=O+(rowbase+q0+wid*QBLK)*DM+hv*D;
  { bf16*stg=(bf16*)(shm+LDS_OST)+wid*2048;
    #pragma unroll
    for(int r=0;r<16;++r){const int orow=crow(r,hi);
      #pragma unroll
      for(int d0=0;d0<2;++d0)stg[orow*64+d0*32+r32]=__float2bfloat16(o[d0][r]*rli[r]);}
    asm volatile("s_waitcnt lgkmcnt(0)":::"memory");
    #pragma unroll
    for(int i=0;i<4;++i){const int row=i*8+(lane>>3),ch=lane&7; const u32x4 v=*(const u32x4*)(stg+row*64+ch*8); ATTN_STORE16(Ow+(long)row*DM+ch*8,v);} }
  asm volatile("s_waitcnt lgkmcnt(0)\n\ts_barrier":::"memory");
  #undef DMA_K
  #undef DMA_V
  #undef CMASK
  #undef START
  #undef RESC
  #undef ROT
}
__device__ __forceinline__ void pv4(f32x16*o,int vb,bf16x8 pa0,bf16x8 pa1,bf16x8 pa2,bf16x8 pa3){
  #pragma unroll
  for(int d0=0;d0<4;++d0){s16x4 lo[4],hi[4];
    #pragma unroll
    for(int ks=0;ks<4;++ks){
      asm volatile("ds_read_b64_tr_b16 %0,%1 offset:%c2":"=&v"(lo[ks]):"v"(vb),"i"(d0*4096+ks*1024):"memory");
      asm volatile("ds_read_b64_tr_b16 %0,%1 offset:%c2":"=&v"(hi[ks]):"v"(vb),"i"(d0*4096+ks*1024+512):"memory");}
    asm volatile("s_waitcnt lgkmcnt(0)":::"memory");SBAR();
    #define PK(k) (bf16x8){lo[k][0],lo[k][1],lo[k][2],lo[k][3],hi[k][0],hi[k][1],hi[k][2],hi[k][3]}
    o[d0]=__builtin_amdgcn_mfma_f32_32x32x16_bf16(pa0,PK(0),o[d0],0,0,0);
    o[d0]=__builtin_amdgcn_mfma_f32_32x32x16_bf16(pa1,PK(1),o[d0],0,0,0);
    o[d0]=__builtin_amdgcn_mfma_f32_32x32x16_bf16(pa2,PK(2),o[d0],0,0,0);
    o[d0]=__builtin_amdgcn_mfma_f32_32x32x16_bf16(pa3,PK(3),o[d0],0,0,0);
    #undef PK
  }
}
constexpr int L2_K=0, L2_V=NSLOT*SLOTB, L2_WS=L2_V+NSLOT*2*SLOTB, L2_OST=L2_WS+NW*64*4, L2_BYTES=L2_OST+NW*8192;
template<int THRL> __device__ __forceinline__ void attn_pass128(int tid,int b,int h,int hv,int qb,const bf16*Q,const bf16*__restrict__ K,const bf16*__restrict__ V,char*shm,const bool pre,bf16x8 (&qr)[4]){
  const int lane=tid&63,r32=lane&31,hi=lane>>5; const int wid=__builtin_amdgcn_readfirstlane(tid>>6);
  const long rowbase=(long)b*SEQ; const int q0=qb*QB;
  const bf16*Qw=Q+(rowbase+q0+wid*QBLK)*DM+h*D;
  const bf16*Kh=K+rowbase*DM+h*D,*Vh=V+rowbase*DM+hv*128;
  const unsigned lds0=(unsigned)(uintptr_t)shm;
  float*wsf=(float*)(shm+L2_WS)+wid*64;
  const unsigned ksrc=(unsigned)(lane*DM+wid*8)*2u;
  const unsigned vsrc=(unsigned)((16*(wid&3)+(lane>>2))*DM+(wid>>2)*32+(lane&3)*8)*2u;
  const unsigned kdst=lds0+L2_K+wid*1024, vdst=lds0+L2_V+wid*1024;
  #define DMA_K(t,slot) glds16(Kh+(long)(t)*KVBLK*DM,ksrc,(unsigned)__builtin_amdgcn_readfirstlane(kdst+(slot)))
  #define DMA_V(t,slot) do{ glds16(Vh+(long)(t)*KVBLK*DM,vsrc,(unsigned)__builtin_amdgcn_readfirstlane(vdst+2*(slot))); glds16(Vh+(long)(t)*KVBLK*DM+64,vsrc,(unsigned)__builtin_amdgcn_readfirstlane(vdst+2*(slot)+8192)); }while(0)
  const int vb0=(int)(lds0+L2_V)+((lane>>4)&1)*32+(lane&3)*8+(4*hi+((lane&15)>>2))*64;
  const char*Kbase=shm+L2_K; bf16x8 kf[8];
  const lds_cptr shm3=(lds_cptr)shm; const lds_cptr kp0=shm3+L2_K+hi*1024+r32*16; const lds_cptr vp0=shm3+L2_V+((lane>>4)&1)*32+(lane&3)*8+(4*hi+((lane&15)>>2))*64;
  const int NT=(q0+QB)/KVBLK;
  if(!pre){ DMA_K(0,0);DMA_V(0,0);DMA_K(1,SLOTB);
    #pragma unroll
    for(int d0=0;d0<4;++d0)qr[d0]=*reinterpret_cast<const bf16x8*>(&Qw[(long)r32*DM+d0*16+hi*8]); }
  float mhat=0.f,l_reg=0.f;f32x16 o[4];o[0]=f32x16{};o[1]=f32x16{};o[2]=f32x16{};o[3]=f32x16{}; const f32x16 zero16=f32x16{};
  const int qrel=wid*QBLK+r32;
  #define CMASK(P0,P1,t) do{int jb_=(t)-(NT-4); if(jb_>=0)cmask(P0,P1,jb_,qrel,hi);}while(0)
  bool resc=false;
  #define START(P0,P1) do{ const float rm=rowmax(P0,P1); resc=false; mhat=fadd_s(mhat,rm); \
    _Pragma("unroll") for(int r=0;r<16;++r)P0[r]=__builtin_amdgcn_exp2f(fsub_s(P0[r],mhat)); }while(0)
  #define RESC() do{ if(resc){ asm volatile("s_waitcnt lgkmcnt(0)":::"memory"); \
      _Pragma("unroll") for(int d_=0;d_<4;++d_) _Pragma("unroll") for(int r=0;r<16;++r)o[d_][r]*=wsf[crow(r,hi)]; } }while(0)
  f32x16 pA0,pA1,pB0,pB1;
  int sl_prev=0,sl_cur=0,sl_next=SLOTB;
  #define ROT() do{sl_prev=sl_cur;sl_cur=sl_next;sl_next=(sl_next==(NSLOT-1)*SLOTB)?0:sl_next+SLOTB;}while(0)
  if(!pre){ DMA_K(2,2*SLOTB);
    WAIT_BAR(4); }
  else { WAIT_BAR(12); }
  qkt(pA0,pA1,Kbase,qr,zero16,r32,hi);asm volatile("s_nop 15\n\ts_nop 7":"+v"(pA0),"+v"(pA1));CMASK(pA0,pA1,0);
  START(pA0,pA1);
  _Pragma("unroll") for(int r=0;r<16;++r)pA1[r]=__builtin_amdgcn_exp2f(fsub_s(pA1[r],mhat));
  WAIT_BAR(0);
  DMA_K(3,0);DMA_V(1,SLOTB);
  ROT();
  kload8(kf,kp0+sl_cur);
  WAIT_BAR(3);
  s16x4 vlo[8],vhi[8]; u32x4 pw0,pw1,pw2,pw3;
  #define PKW(P,B) cvtpk_s(P[B],P[B+1])
  #define PAF(k) __builtin_bit_cast(bf16x8,pw##k)
  #define VFR(i) (bf16x8){vlo[i][0],vlo[i][1],vlo[i][2],vlo[i][3],vhi[i][0],vhi[i][1],vhi[i][2],vhi[i][3]}
  #define PIN(x) asm volatile("":"+v"(x))
  #define MX3(a,b,c) __builtin_fmaxf(__builtin_fmaxf((a),(b)),(c))
  #define GAPA(MF,A0,A1,A2,A3,W0,W1,PW) do{ MF; sacc+=A0; sacc+=A1; sacc+=A2; sacc+=A3; PIN(sacc); W0; W1; PIN(PW); SBAR(); }while(0)
  #define EX(v) __builtin_amdgcn_exp2f(fsub_s((v),mhat))
  #define VRDX(i,f) do{ vlo[i]=vtr(vp_+(((f)>>2)*4096+((f)&3)*1024)); vhi[i]=vtr(vp_+(((f)>>2)*4096+((f)&3)*1024+512)); }while(0)
  #define GAPB(MF,X,B,RL) do{ MF; { const float a_=X[B]-mhat, b_=X[B+1]-mhat; X[B]=__builtin_amdgcn_exp2f(a_); X[B+1]=__builtin_amdgcn_exp2f(b_); } RL; PIN(X); SBAR(); }while(0)
  #define VRD(i) do{ vlo[i]=vtr(vp_+(((i)>>2)*4096+((i)&3)*1024)); vhi[i]=vtr(vp_+(((i)>>2)*4096+((i)&3)*1024+512)); }while(0)
  #define KRD(G,j) do{ if(G){ kload2(kf,kp0+sl_next,j); SBAR(); } }while(0)
  #define STEP(C0,C1,P0,P1,t,GK,GV,GL) do{ SBAR(); \
    const lds_cptr vp_=vp0+2*sl_prev; \
    VRD(0); SBAR(); float sacc=(P0[0]+P0[1]); \
    GAPA(C0=__builtin_amdgcn_mfma_f32_32x32x16_bf16(kf[0],qr[0],zero16,0,0,0), P0[2],P0[3],P0[4],P0[5],     pw0[0]=PKW(P0,0), pw0[1]=PKW(P0,2), pw0); \
    VRD(4); SBAR(); GAPA(C1=__builtin_amdgcn_mfma_f32_32x32x16_bf16(kf[1],qr[0],zero16,0,0,0), P0[6],P0[7],P0[8],P0[9],     pw0[2]=PKW(P0,4), pw0[3]=PKW(P0,6), pw0); \
    VRD(1); SBAR(); GAPA(C0=__builtin_amdgcn_mfma_f32_32x32x16_bf16(kf[2],qr[1],C0,0,0,0),   P0[10],P0[11],P0[12],P0[13], pw1[0]=PKW(P0,8), pw1[1]=PKW(P0,10), pw1); \
    VRD(5); SBAR(); GAPA(C1=__builtin_amdgcn_mfma_f32_32x32x16_bf16(kf[3],qr[1],C1,0,0,0),   P0[14],P0[15],P1[0],P1[1],   pw1[2]=PKW(P0,12),pw1[3]=PKW(P0,14), pw1); \
    VRD(2); SBAR(); GAPA(C0=__builtin_amdgcn_mfma_f32_32x32x16_bf16(kf[4],qr[2],C0,0,0,0),   P1[2],P1[3],P1[4],P1[5],     pw2[0]=PKW(P1,0), pw2[1]=PKW(P1,2), pw2); \
    VRD(6); SBAR(); GAPA(C1=__builtin_amdgcn_mfma_f32_32x32x16_bf16(kf[5],qr[2],C1,0,0,0),   P1[6],P1[7],P1[8],P1[9],     pw2[2]=PKW(P1,4), pw2[3]=PKW(P1,6), pw2); \
    VRD(3); SBAR(); GAPA(C0=__builtin_amdgcn_mfma_f32_32x32x16_bf16(kf[6],qr[3],C0,0,0,0),   P1[10],P1[11],P1[12],P1[13], pw3[0]=PKW(P1,8), pw3[1]=PKW(P1,10), pw3); \
    VRD(7); SBAR(); GAPA(C1=__builtin_amdgcn_mfma_f32_32x32x16_bf16(kf[7],qr[3],C1,0,0,0),   P1[14],P1[15],0.f,0.f,       pw3[2]=PKW(P1,12),pw3[3]=PKW(P1,14), pw3); \
    l_reg+=sacc; \
    if(GK){DMA_K((t)+3,sl_cur);} if(GV){DMA_V((t)+1,sl_next);} \
    CMASK(C0,C1,t); \
    { float a=MX3(C0[0],C0[1],C1[0]),b=MX3(C0[2],C0[3],C1[1]); a=MX3(a,C1[2],C1[3]); \
      _Pragma("unroll") for(int r=4;r<16;r+=4){a=MX3(a,C0[r],C0[r+1]);b=MX3(b,C0[r+2],C0[r+3]);a=MX3(a,C1[r],C1[r+1]);b=MX3(b,C1[r+2],C1[r+3]);} \
      float rm=__builtin_fmaxf(a,b); { auto rr=__builtin_amdgcn_permlane32_swap(__float_as_uint(rm),__float_as_uint(rm),false,false); rm=__builtin_fmaxf(__uint_as_float(rr[0]),__uint_as_float(rr[1])); } \
      resc=false; \
      rm-=mhat; \
      if(__builtin_expect(__any(rm>(float)THRL),0)){ const float dl=__builtin_fmaxf(rm,0.f); mhat+=dl; \
        const float f=__builtin_amdgcn_exp2f(-dl); l_reg*=f; if(hi==0)wsf[r32]=f; resc=true; } } \
    SBAR(); \
    GAPB(o[0]=__builtin_amdgcn_mfma_f32_32x32x16_bf16(PAF(0),VFR(0),o[0],0,0,0), C0,0,  VRDX(0,8)); \
    GAPB(o[1]=__builtin_amdgcn_mfma_f32_32x32x16_bf16(PAF(0),VFR(4),o[1],0,0,0), C0,2,  VRDX(4,12)); \
    KRD(GL,0); GAPB(o[0]=__builtin_amdgcn_mfma_f32_32x32x16_bf16(PAF(1),VFR(1),o[0],0,0,0), C0,4,  VRDX(1,9)); \
    KRD(GL,1); GAPB(o[1]=__builtin_amdgcn_mfma_f32_32x32x16_bf16(PAF(1),VFR(5),o[1],0,0,0), C0,6,  VRDX(5,13)); \
    KRD(GL,2); GAPB(o[0]=__builtin_amdgcn_mfma_f32_32x32x16_bf16(PAF(2),VFR(2),o[0],0,0,0), C0,8,  VRDX(2,10)); \
    KRD(GL,3); GAPB(o[1]=__builtin_amdgcn_mfma_f32_32x32x16_bf16(PAF(2),VFR(6),o[1],0,0,0), C0,10, VRDX(6,14)); \
    GAPB(o[0]=__builtin_amdgcn_mfma_f32_32x32x16_bf16(PAF(3),VFR(3),o[0],0,0,0), C0,12, VRDX(3,11)); \
    GAPB(o[1]=__builtin_amdgcn_mfma_f32_32x32x16_bf16(PAF(3),VFR(7),o[1],0,0,0), C0,14, VRDX(7,15)); \
    GAPB(o[2]=__builtin_amdgcn_mfma_f32_32x32x16_bf16(PAF(0),VFR(0),o[2],0,0,0), C1,0,  (void)0); \
    GAPB(o[3]=__builtin_amdgcn_mfma_f32_32x32x16_bf16(PAF(0),VFR(4),o[3],0,0,0), C1,2,  (void)0); \
    GAPB(o[2]=__builtin_amdgcn_mfma_f32_32x32x16_bf16(PAF(1),VFR(1),o[2],0,0,0), C1,4,  (void)0); \
    GAPB(o[3]=__builtin_amdgcn_mfma_f32_32x32x16_bf16(PAF(1),VFR(5),o[3],0,0,0), C1,6,  (void)0); \
    GAPB(o[2]=__builtin_amdgcn_mfma_f32_32x32x16_bf16(PAF(2),VFR(2),o[2],0,0,0), C1,8,  (void)0); \
    GAPB(o[3]=__builtin_amdgcn_mfma_f32_32x32x16_bf16(PAF(2),VFR(6),o[3],0,0,0), C1,10, (void)0); \
    GAPB(o[2]=__builtin_amdgcn_mfma_f32_32x32x16_bf16(PAF(3),VFR(3),o[2],0,0,0), C1,12, (void)0); \
    GAPB(o[3]=__builtin_amdgcn_mfma_f32_32x32x16_bf16(PAF(3),VFR(7),o[3],0,0,0), C1,14, (void)0); \
    }while(0)
  int t=1;
  #undef CMASK
  #define CMASK(P0,P1,t) do{}while(0)
  for(;t+5<NT;t+=2){
    STEP(pB0,pB1,pA0,pA1,t,true,true,true);     WAIT_BAR(3); RESC(); ROT();
    STEP(pA0,pA1,pB0,pB1,t+1,true,true,true);   WAIT_BAR(3); RESC(); ROT();
  }
  #undef CMASK
  #define CMASK(P0,P1,t) do{int jb_=(t)-(NT-4); if(jb_>=0)cmask(P0,P1,jb_,qrel,hi);}while(0)
  #define ENDW(tt) do{ if((tt)+3<NT){WAIT_BAR(3);} else if((tt)+2<NT){WAIT_BAR(2);} else {WAIT_BAR(0);} }while(0)
  for(;t+1<NT;t+=2){
    STEP(pB0,pB1,pA0,pA1,t,(t+3<NT),(t+1<NT),(t+1<NT));       ENDW(t);   RESC(); ROT();
    STEP(pA0,pA1,pB0,pB1,t+1,(t+4<NT),(t+2<NT),(t+2<NT));     ENDW(t+1); RESC(); ROT();
  }
  STEP(pB0,pB1,pA0,pA1,NT-1,false,false,false); RESC();
  { float sacc=pB0[0]+pB0[1]; _Pragma("unroll") for(int r=2;r<16;++r)sacc+=pB0[r]; _Pragma("unroll") for(int r=0;r<16;++r)sacc+=pB1[r]; l_reg+=sacc;
    pw0=(u32x4){PKW(pB0,0),PKW(pB0,2),PKW(pB0,4),PKW(pB0,6)};pw1=(u32x4){PKW(pB0,8),PKW(pB0,10),PKW(pB0,12),PKW(pB0,14)};pw2=(u32x4){PKW(pB1,0),PKW(pB1,2),PKW(pB1,4),PKW(pB1,6)};pw3=(u32x4){PKW(pB1,8),PKW(pB1,10),PKW(pB1,12),PKW(pB1,14)};
    SBAR(); pv4(o,vb0+2*sl_cur,PAF(0),PAF(1),PAF(2),PAF(3)); }
  #undef PKW
  #undef PAF
  #undef VFR
  #undef PIN
  #undef MX3
  #undef GAPA
  #undef GAPB
  #undef EX
  #undef VRD
  #undef VRDX
  #undef KRD
  #undef STEP
  #undef ENDW
  {auto rr=__builtin_amdgcn_permlane32_swap(__float_as_uint(l_reg),__float_as_uint(l_reg),false,false);l_reg=__uint_as_float(rr[0])+__uint_as_float(rr[1]);}
  if(hi==0)wsf[32+r32]=l_reg;asm volatile("s_waitcnt lgkmcnt(0)":::"memory");
  float rli[16];
  #pragma unroll
  for(int r=0;r<16;++r)rli[r]=__builtin_amdgcn_rcpf(wsf[32+crow(r,hi)]);
  { bf16*stg=(bf16*)(shm+L2_OST)+wid*4096;
    #pragma unroll
    for(int r=0;r<16;++r){const int orow=crow(r,hi);
      #pragma unroll
      for(int d0=0;d0<4;++d0)stg[orow*128+d0*32+r32]=__float2bfloat16(o[d0][r]*rli[r]);} }
  asm volatile("s_waitcnt lgkmcnt(0)\n\ts_barrier":::"memory");
  #undef DMA_K
  #undef DMA_V
  #undef CMASK
  #undef START
  #undef RESC
  #undef ROT
}

__device__ __forceinline__ void attn_pro128(int tid,int b,int h,int hv,int qb,const bf16*Q,const bf16*__restrict__ K,const bf16*__restrict__ V,char*shm,bf16x8 (&qr)[4]){
  const int lane=tid&63,r32=lane&31,hi=lane>>5; const int wid=__builtin_amdgcn_readfirstlane(tid>>6);
  const long rowbase=(long)b*SEQ; const int q0=qb*QB;
  const bf16*Qw=Q+(rowbase+q0+wid*QBLK)*DM+h*D;
  const bf16*Kh=K+rowbase*DM+h*D,*Vh=V+rowbase*DM+hv*128;
  const unsigned lds0=(unsigned)(uintptr_t)shm;
  const unsigned ksrc=(unsigned)(lane*DM+wid*8)*2u;
  const unsigned vsrc=(unsigned)((16*(wid&3)+(lane>>2))*DM+(wid>>2)*32+(lane&3)*8)*2u;
  const unsigned kdst=lds0+L2_K+wid*1024, vdst=lds0+L2_V+wid*1024;
  glds16(Kh,ksrc,(unsigned)__builtin_amdgcn_readfirstlane(kdst));
  glds16(Vh,vsrc,(unsigned)__builtin_amdgcn_readfirstlane(vdst)); glds16(Vh+64,vsrc,(unsigned)__builtin_amdgcn_readfirstlane(vdst+8192));
  glds16(Kh+(long)KVBLK*DM,ksrc,(unsigned)__builtin_amdgcn_readfirstlane(kdst+SLOTB));
  #pragma unroll
  for(int d0=0;d0<4;++d0)qr[d0]=*reinterpret_cast<const bf16x8*>(&Qw[(long)r32*DM+d0*16+hi*8]);
  glds16(Kh+(long)2*KVBLK*DM,ksrc,(unsigned)__builtin_amdgcn_readfirstlane(kdst+2*SLOTB));
}
template<int THRL> __device__ __forceinline__ void diff_cu128(int tid,int b,int h,int s_,const bf16*Q,const bf16*K,const bf16*V,bf16*park,bf16*AO,float lam,const float*subln,float sc,char*shm){
  bf16x8 qr[4]; bool pre=false;
  #pragma unroll 1
  for(int p=0;p<8;++p){
    const int i=p>>1,mp=p&1; const int qb= i==0?15-s_: i==1?8+s_: i==2?7-s_: s_;
    attn_pass128<THRL>(tid,b,2*h+mp,h,qb,Q,K,V,shm,pre,qr);
    const bool hn=p+1<8; const int ni=(p+1)>>1,nmp=(p+1)&1; const int nqb= ni==0?15-s_: ni==1?8+s_: ni==2?7-s_: s_;
    int t2=tid; asm volatile("":"+v"(t2));
    const int lane=t2&63; const int wid=__builtin_amdgcn_readfirstlane(t2>>6);
    const long row0=(long)b*SEQ+qb*QB+wid*QBLK;
    const char*stg=shm+L2_OST+wid*8192+(lane>>4)*256+(lane&15)*16;
    const unsigned goff=(unsigned)(((lane>>4)*DM+h*128+(lane&15)*8)*2);
    char*pk=(char*)(park+row0*DM); char*ao=(char*)(AO+row0*DM);
    if(mp==0){
      if(hn)attn_pro128(t2,b,2*h+nmp,h,nqb,Q,K,V,shm,qr);
      #pragma unroll 2
      for(int i2=0;i2<8;++i2){ const u32x4 v=*(const u32x4*)(stg+i2*1024); *(u32x4*)(pk+goff+(unsigned)i2*(4*DM*2))=v; }
    } else {
      float sl[8];
      #pragma unroll
      for(int j=0;j<8;++j)sl[j]=subln[(lane&15)*8+j]*sc;
      u32x4 v0a[8];
      #pragma unroll
      for(int i2=0;i2<8;++i2)v0a[i2]=*(const u32x4*)(pk+goff+(unsigned)i2*(4*DM*2));
      #pragma unroll
      for(int i2=0;i2<8;++i2)asm volatile("":"+v"(v0a[i2]));
      if(hn)attn_pro128(t2,b,2*h+nmp,h,nqb,Q,K,V,shm,qr);
      #pragma unroll
      for(int i2=0;i2<8;++i2){ const u32x4 v1=*(const u32x4*)(stg+i2*1024); const u32x4 v0=v0a[i2];
        float d[8];
        #pragma unroll
        for(int j=0;j<4;++j){ d[2*j]=__uint_as_float(v0[j]<<16)-lam*__uint_as_float(v1[j]<<16); d[2*j+1]=__uint_as_float(v0[j]&0xffff0000u)-lam*__uint_as_float(v1[j]&0xffff0000u); }
        float ss=0.f;
        #pragma unroll
        for(int j=0;j<8;++j)ss+=d[j]*d[j];
        ss+=__shfl_xor(ss,1);ss+=__shfl_xor(ss,2);ss+=__shfl_xor(ss,4);ss+=__shfl_xor(ss,8);
        const float rn=__builtin_amdgcn_rsqf(ss*(1.f/128.f)+1e-6f);
        u32x4 w;
        #pragma unroll
        for(int j=0;j<4;++j)w[j]=cvtpk_s(d[2*j]*rn*sl[2*j],d[2*j+1]*rn*sl[2*j+1]);
        *(u32x4*)(ao+goff+(unsigned)i2*(4*DM*2))=w;}
    }
    asm volatile("s_waitcnt lgkmcnt(0)":::"memory");
    pre=hn;
  }
}
constexpr int ATTN_LDS_BYTES=LDS_BYTES;
#undef SBAR
#undef WAIT_BAR
}

__device__ __forceinline__ void attn_diff_fast(const int tid, unsigned char* lds_raw, const Args& A) {
    const int G = gridDim.x, bx = blockIdx.x; const int vcu0 = (G % 8 == 0) ? (bx % 8) * (G / 8) + bx / 8 : bx;
    const attn_body::bf16* Q = (const attn_body::bf16*)(A.ws + WS_Q); const attn_body::bf16* K = (const attn_body::bf16*)(A.ws + WS_K); const attn_body::bf16* V = (const attn_body::bf16*)(A.ws + WS_V);
    attn_body::bf16* O0 = (attn_body::bf16*)A.out; attn_body::bf16* O1 = O0 + (size_t)T * DM;
    for (int v = vcu0; v < 256; v += G) {
        const int bh = v >> 2, s_ = v & 3, b = bh >> 3, h = bh & 7;
#pragma unroll 1
        for (int i = 0; i < 16; ++i) {
            const int combo = i & 3, qsel = i >> 2, m = combo >> 1, vh = combo & 1;
            const int qb = qsel == 0 ? 15 - s_ : qsel == 1 ? 8 + s_ : qsel == 2 ? 7 - s_ : s_;
            attn_body::attn_unit<8>(tid, b, h * 2 + m, h * 2 + vh, qb, Q, K, V, m ? O1 : O0, (char*)lds_raw);
        }
    }
}
__device__ __forceinline__ void attn_diff_fast2(const int tid, unsigned char* lds_raw, const Args& A) {
    const int G = gridDim.x, bx = blockIdx.x; const int vcu0 = (G % 8 == 0) ? (bx % 8) * (G / 8) + bx / 8 : bx; const int lane = tid & 63;
    const attn_body::bf16* Q = (const attn_body::bf16*)(A.ws + WS_Q); const attn_body::bf16* K = (const attn_body::bf16*)(A.ws + WS_K); const attn_body::bf16* V = (const attn_body::bf16*)(A.ws + WS_V);
    attn_body::bf16* park = (attn_body::bf16*)A.out; attn_body::bf16* AO = (attn_body::bf16*)(A.ws + WS_AO);
    const float d1 = A.a_lq1[lane] * A.a_lk1[lane], d2 = A.a_lq2[lane] * A.a_lk2[lane];
    const float lam = __uint_as_float(__builtin_amdgcn_readfirstlane(__float_as_uint(__expf(wave_sum(d1)) - __expf(wave_sum(d2)) + 0.2f)));
    for (int v = vcu0; v < 256; v += G) {
        const int bh = v >> 2, s_ = v & 3, b = bh >> 3, h = bh & 7;
        attn_body::diff_cu128<8>(tid, b, h, s_, Q, K, V, park, AO, lam, A.a_subln, 0.8f, (char*)lds_raw);
    }
}
__device__ __forceinline__ void diff_combine(Frame& F, const Args& A) {
    const int lane = F.lane;
    const float d1 = A.a_lq1[lane] * A.a_lk1[lane], d2 = A.a_lq2[lane] * A.a_lk2[lane];
    const float lam = __expf(wave_sum(d1)) - __expf(wave_sum(d2)) + 0.2f;
    const bf16_t* O0 = (const bf16_t*)A.out; const bf16_t* O1 = O0 + (size_t)T * DM; bf16_t* AO = (bf16_t*)(F.ws + WS_AO);
    float sl[16];
#pragma unroll
    for (int j = 0; j < 16; ++j) sl[j] = A.a_subln[16 * (lane & 7) + j] * 0.8f;
    const int gw = F.vcu * NWAVES + F.wave, NGW = F.G * NWAVES;
    for (int row = gw; row < T; row += NGW) {
        const size_t off = (size_t)row * DM + 16 * lane;
        const u32x4 a0 = *(const u32x4*)(O0 + off), a1 = *(const u32x4*)(O0 + off + 8), b0 = *(const u32x4*)(O1 + off), b1 = *(const u32x4*)(O1 + off + 8);
        float d[16];
#pragma unroll
        for (int j = 0; j < 4; ++j) { d[2 * j] = bflo(a0[j]) - lam * bflo(b0[j]); d[2 * j + 1] = bfhi(a0[j]) - lam * bfhi(b0[j]); d[8 + 2 * j] = bflo(a1[j]) - lam * bflo(b1[j]); d[8 + 2 * j + 1] = bfhi(a1[j]) - lam * bfhi(b1[j]); }
        float ss = 0.f;
#pragma unroll
        for (int j = 0; j < 16; ++j) ss += d[j] * d[j];
        ss += __shfl_xor(ss, 1); ss += __shfl_xor(ss, 2); ss += __shfl_xor(ss, 4);
        const float rn = __builtin_amdgcn_rsqf(ss * (1.f / 128.f) + EPS);
        u32x4 w0, w1;
#pragma unroll
        for (int j = 0; j < 4; ++j) { w0[j] = cvtpk(d[2 * j] * rn * sl[2 * j], d[2 * j + 1] * rn * sl[2 * j + 1]); w1[j] = cvtpk(d[8 + 2 * j] * rn * sl[8 + 2 * j], d[8 + 2 * j + 1] * rn * sl[8 + 2 * j + 1]); }
        *(u32x4*)(AO + off) = w0; *(u32x4*)(AO + off + 8) = w1;
    }
}

constexpr int LDS_RT = 131072 + 8448;
__device__ __forceinline__ void sb_glds16(const void* sbase, unsigned voff, unsigned lds_dst) { unsigned keep;
    asm volatile("s_nop 4\n\ts_mov_b32 %0, m0\n\ts_mov_b32 m0, %3\n\ts_nop 0\n\tglobal_load_lds_dwordx4 %1, %2\n\ts_mov_b32 m0, %0" : "=&s"(keep) : "v"(voff), "s"(sbase), "s"(lds_dst) : "memory"); }
__device__ __forceinline__ void router_phase(Frame& F, const Args& A, int layer) {
    const int lane = F.lane, r16 = lane & 15, kq = lane >> 4;
    LAS unsigned* hist = (LAS unsigned*)(F.lds + LDS_RT); LAS unsigned* base = hist + 32;
    const bf16_t* HB = (const bf16_t*)(F.ws + WS_HB); float* RSTD = (float*)(F.ws + WS_RSTD_FF);
    const bf16_t* WRh = (const bf16_t*)(F.ws + WS_WR) + (size_t)(layer * 2 + 0) * 64 * 1024; const bf16_t* WRl = (const bf16_t*)(F.ws + WS_WR) + (size_t)(layer * 2 + 1) * 64 * 1024;
    unsigned* cnt = (unsigned*)(F.ws + WS_CTL) + CW_CNT + layer * 32; int* rowtok = (int*)(F.ws + WS_ROWTOK); float* rowgate = (float*)(F.ws + WS_ROWGATE); float* rowrs = (float*)(F.ws + WS_ROWRS); unsigned* TS = (unsigned*)(F.ws + WS_TOKSLOT);
    const float* bg = A.b_group + layer * NG; const float* be = A.b_expert + layer * NE;
    const unsigned lds0 = (unsigned)(__SIZE_TYPE__)F.lds;
    const unsigned abuf = lds0 + 49152u + (unsigned)F.wave * 8192u;
    unsigned voA[4], voW[3]; int wpc[3];
#pragma unroll
    for (int j = 0; j < 4; ++j) { const int rr = 4 * j + (lane >> 4); voA[j] = (unsigned)(rr * (DM * 2) + (((lane & 15) ^ rr) << 4)); }
#pragma unroll
    for (int i = 0; i < 3; ++i) { const int p = F.wave + 8 * i, hl = p / 12, rg = p % 12, row = 4 * rg + (lane >> 4); wpc[i] = p;
        voW[i] = (unsigned)((hl * 64 * 1024 + row * 1024) * 2 + (((lane & 15) ^ (row & 15)) << 4)); }
    for (int round = F.vcu; round < T / 128; round += F.G) {
        const int row0 = round * 128 + F.wave * 16;
        if (F.tid < 32) hist[F.tid] = 0u;
        const char* src = (const char*)(HB + (size_t)row0 * DM);
#define RT_DMA(c, buf) do { _Pragma("unroll") for (int i_ = 0; i_ < 3; ++i_) sb_glds16((const char*)WRh + (c) * 256, voW[i_], (unsigned)__builtin_amdgcn_readfirstlane((int)(lds0 + (buf) * 24576u + (unsigned)wpc[i_] * 1024u))); \
            _Pragma("unroll") for (int j_ = 0; j_ < 4; ++j_) sb_glds16(src + (c) * 256, voA[j_], (unsigned)__builtin_amdgcn_readfirstlane((int)(abuf + (buf) * 4096u + j_ * 1024u))); } while (0)
        RT_DMA(0, 0);
        f32x4 acc[3] = {(f32x4){0.f, 0.f, 0.f, 0.f}, (f32x4){0.f, 0.f, 0.f, 0.f}, (f32x4){0.f, 0.f, 0.f, 0.f}}; float ssq = 0.f;
#pragma unroll 1
        for (int c = 0; c < 8; ++c) {
            asm volatile("s_waitcnt vmcnt(0) lgkmcnt(0)\n\ts_barrier" ::: "memory");
            if (c + 1 < 8) RT_DMA(c + 1, (c + 1) & 1);
            const LAS unsigned char* ap = F.lds + 49152 + F.wave * 8192 + (c & 1) * 4096 + r16 * 256;
            const LAS unsigned char* wp = F.lds + (c & 1) * 24576 + r16 * 256;
#pragma unroll
            for (int ks = 0; ks < 4; ++ks) {
                const int sw = ((4 * ks + kq) ^ r16) << 4;
                const u32x4 ah = *(const LAS u32x4*)(ap + sw);
#pragma unroll
                for (int i = 0; i < 4; ++i) { const float lo_ = bflo(ah[i]), hi_ = bfhi(ah[i]); ssq += lo_ * lo_ + hi_ * hi_; }
                const bf16x8 ahv = __builtin_bit_cast(bf16x8, ah);
#pragma unroll
                for (int cb = 0; cb < 3; ++cb) {
                    const bf16x8 bh = *(const LAS bf16x8*)(wp + cb * 4096 + sw), bl = *(const LAS bf16x8*)(wp + 12288 + cb * 4096 + sw);
                    acc[cb] = MFMA16(ahv, bh, acc[cb]); acc[cb] = MFMA16(ahv, bl, acc[cb]);
                }
            }
        }
#undef RT_DMA
        LAS unsigned char* slot = F.lds + 49152 + F.wave * 8192;
        ssq += __shfl_xor(ssq, 16); ssq += __shfl_xor(ssq, 32);
        const float rstd = __builtin_amdgcn_rsqf(ssq * (1.f / DM) + EPS);
        LAS float* lg = (LAS float*)slot;
        asm volatile("s_waitcnt lgkmcnt(0)" ::: "memory");
#pragma unroll
        for (int cb = 0; cb < 3; ++cb)
#pragma unroll
            for (int r = 0; r < 4; ++r) lg[(4 * kq + r) * 49 + cb * 16 + r16] = acc[cb][r];
        asm volatile("s_waitcnt lgkmcnt(0)" ::: "memory");
        int e1 = 0, e2 = 0; float g1 = 0.f, g2 = 0.f; unsigned rk1 = 0, rk2 = 0;
        if (lane < 16) {
            const LAS float* lr = lg + lane * 49;
            float gl[4];
#pragma unroll
            for (int j = 0; j < 4; ++j) gl[j] = lr[32 + j] * rstd + bg[j];
            int gi = 0; float gm = gl[0];
#pragma unroll
            for (int j = 1; j < 4; ++j) if (gl[j] > gm) { gm = gl[j]; gi = j; }
            float gsum = 0.f;
#pragma unroll
            for (int j = 0; j < 4; ++j) gsum += __expf(gl[j] - gm);
            const float gwt = 1.f / gsum;
            float el[8];
#pragma unroll
            for (int j = 0; j < 8; ++j) el[j] = lr[gi * 8 + j] * rstd + be[gi * 8 + j];
            int i1 = 0; float m1 = el[0];
#pragma unroll
            for (int j = 1; j < 8; ++j) if (el[j] > m1) { m1 = el[j]; i1 = j; }
            int i2 = -1; float m2 = -3.0e38f;
#pragma unroll
            for (int j = 0; j < 8; ++j) if (j != i1 && el[j] > m2) { m2 = el[j]; i2 = j; }
            const float p2 = __expf(m2 - m1), inv = 1.f / (1.f + p2);
            g1 = gwt * inv; g2 = gwt * p2 * inv; e1 = gi * 8 + i1; e2 = gi * 8 + i2;
        }
        __syncthreads();
        if (lane < 16) { rk1 = __hip_atomic_fetch_add(&hist[e1], 1u, __ATOMIC_RELAXED, __HIP_MEMORY_SCOPE_WORKGROUP); rk2 = __hip_atomic_fetch_add(&hist[e2], 1u, __ATOMIC_RELAXED, __HIP_MEMORY_SCOPE_WORKGROUP); }
        __syncthreads();
        if (F.tid < 32) base[F.tid] = atomicAdd(&cnt[F.tid], hist[F.tid]);
        __syncthreads();
        if (lane < 16) {
            const int row = row0 + lane; const unsigned s1 = base[e1] + rk1, s2 = base[e2] + rk2;
            RSTD[row] = rstd;
            rowtok[e1 * ECAP + s1] = row; rowgate[e1 * ECAP + s1] = g1; rowrs[e1 * ECAP + s1] = rstd; rowtok[e2 * ECAP + s2] = row; rowgate[e2 * ECAP + s2] = g2; rowrs[e2 * ECAP + s2] = rstd;
            TS[2 * row] = ((unsigned)e1 << 16) | s1; TS[2 * row + 1] = ((unsigned)e2 << 16) | s2;
        }
        __syncthreads();
    }
}

#define XB_TMO      128
#define XB_XCNT(j)  (256  + 64 * (j))
#define XB_XSUB(j)  (1280 + 64 * (j))
#define XB_XGEN(j)  (2304 + 64 * (j))
#define XB_TOP      3328
#define XB_TOPGEN   3392
#define XCD_BAR_WORDS 3456
#define XB_SPIN_CAP (1u << 20)
constexpr int CW_BAR = 4096;
constexpr int LDS_XB = LDS_BYTES - 64;
__device__ __forceinline__ unsigned xb_ld(unsigned* p)              { return __hip_atomic_load(p, __ATOMIC_RELAXED, __HIP_MEMORY_SCOPE_AGENT); }
__device__ __forceinline__ unsigned xb_add(unsigned* p, unsigned v) { return __hip_atomic_fetch_add(p, v, __ATOMIC_RELAXED, __HIP_MEMORY_SCOPE_AGENT); }
__device__ __forceinline__ unsigned xb_xcc_id() { return (unsigned)__builtin_amdgcn_s_getreg((3 << 11) | 20) & 0xFu; }
#define XB_SPIN(cond, bar) do { unsigned _sp = 0; while (cond) { __builtin_amdgcn_s_sleep(1); \
    if ((++_sp & 255u) == 0u) { if (xb_ld(&(bar)[XB_TMO])) break; if (_sp > XB_SPIN_CAP) { atomicAdd(&(bar)[XB_TMO], 1u); break; } } } } while (0)
__device__ __forceinline__ void xcd_barrier_complete(unsigned* bar, unsigned x, unsigned& nloc, unsigned& nx) {
    const unsigned G = gridDim.x;
    unsigned sum, cnt, mine, sp = 0u;
    for (;;) {
        sum = 0u; cnt = 0u; mine = 0u;
#pragma unroll
        for (unsigned j = 0; j < 16; ++j) { const unsigned c = xb_ld(&bar[XB_XCNT(j)]); sum += c; cnt += (c > 0u) ? 1u : 0u; mine = (j == x) ? c : mine; }
        if (sum == G) break;
        __builtin_amdgcn_s_sleep(1);
        if ((++sp & 255u) == 0u) { if (xb_ld(&bar[XB_TMO])) break; if (sp > XB_SPIN_CAP) { atomicAdd(&bar[XB_TMO], 1u); break; } }
    }
    nloc = mine > 0u ? mine : 1u; nx = cnt > 0u ? cnt : 1u;
}
__device__ __forceinline__ void xcd_barrier(const int tid, unsigned* bar, volatile LAS unsigned* st) {
    asm volatile("s_waitcnt vmcnt(0)" ::: "memory");
    __syncthreads();
    if (tid == 0) {
        const unsigned x = xb_xcc_id();
        __builtin_amdgcn_s_waitcnt(0);
        unsigned nloc = st[0], nx = st[1];
        if (nloc == 0u) { xcd_barrier_complete(bar, x, nloc, nx); st[0] = nloc; st[1] = nx; }
        const unsigned old = xb_add(&bar[XB_XSUB(x)], 1u);
        const unsigned gen = old / nloc;
        if (old + 1u == (gen + 1u) * nloc) {
            __builtin_amdgcn_fence(__ATOMIC_RELEASE, "agent");
            asm volatile("s_waitcnt vmcnt(0)" ::: "memory");
            const unsigned og = xb_add(&bar[XB_TOP], 1u);
            const unsigned tg = og / nx;
            if (og + 1u == (tg + 1u) * nx) xb_add(&bar[XB_TOPGEN], 1u);
            else XB_SPIN(xb_ld(&bar[XB_TOPGEN]) == tg, bar);
            __builtin_amdgcn_fence(__ATOMIC_ACQUIRE, "agent");
            xb_add(&bar[XB_XGEN(x)], 1u);
            asm volatile("s_waitcnt vmcnt(0)" ::: "memory");
        } else {
            XB_SPIN(xb_ld(&bar[XB_XGEN(x)]) == gen, bar);
            __builtin_amdgcn_fence(__ATOMIC_ACQUIRE, "agent");
            asm volatile("s_waitcnt vmcnt(0)" ::: "memory");
        }
    }
    __syncthreads();
}

constexpr int NPHASE = 17;
#ifndef MK_LAUNCHES
#define MK_LAUNCHES 1
#endif
__device__ __forceinline__ Frame make_frame(int wave_s, unsigned char* lds_raw, unsigned char* ws) {
    Frame F; int t_ = fresh_tid(wave_s); int bx = blockIdx.x, G = gridDim.x; asm volatile("" : "+s"(bx), "+s"(G));
    F.lds = (LAS unsigned char*)lds_raw; F.tid = t_; F.lane = t_ & 63; F.wave = __builtin_amdgcn_readfirstlane(t_ >> 6);
    F.G = G; F.vcu = (G % 8 == 0) ? (bx % 8) * (G / 8) + bx / 8 : bx; F.ws = ws; return F;
}
#define PH_IN(k) (A.ph_lo <= (k) && (k) < A.ph_hi)
#define PH_SEAM(k) do { if (PH_IN(k) && PH_IN((k) + 1)) xcd_barrier(fresh_tid(wave_s), (unsigned*)(A.ws + WS_CTL) + CW_BAR, (volatile LAS unsigned*)((LAS unsigned char*)lds_raw + LDS_XB)); } while (0)
#ifndef FASTMASK
#define FASTMASK 15
#endif
template <int BIT, bool GATHER, class Epi, class Sched>
__device__ __forceinline__ void run_gemm(const int tid, unsigned char* lds_raw, int K, const Sched& S, const Epi& E) {
    if ((FASTMASK >> BIT) & 1) gemm_fast<Epi, Sched, GATHER>(tid, (LAS unsigned char*)lds_raw, K, S, E); else gemm_simple(tid, K, S, E);
}
#ifndef PROBE_DUP
#define PROBE_DUP 0
#endif
#define PH_REPS(k) (((PROBE_DUP >> (k)) & 1) ? 2 : 1)
#define PH_REP_BAR(rep, k) do { if ((rep) + 1 < PH_REPS(k)) xcd_barrier(fresh_tid(wave_s), (unsigned*)(A.ws + WS_CTL) + CW_BAR, (volatile LAS unsigned*)((LAS unsigned char*)lds_raw + LDS_XB)); } while (0)
#ifndef FASTATT
#define FASTATT 2
#endif
template <int LAYER>
__device__ __forceinline__ void layer_phases(const int wave_s, unsigned char* lds_raw, const Args& A) {
    unsigned char* ws = A.ws; constexpr int P = 1 + 8 * LAYER;
    if (PH_IN(P + 0)) for (int rep = 0; rep < PH_REPS(P + 0); ++rep) {
        if (stag_on((int)gridDim.x) && (((int)blockIdx.x >> 3) & 1)) {
            Frame F = make_frame(wave_s, lds_raw, ws);
            conv_moe_range(A, ws, LAYER, (LAS float*)(F.lds + F.wave * 16384), F.lane, ((int)blockIdx.x >> 4) * 8 * NWAVES + ((int)blockIdx.x & 7) * NWAVES + F.wave, ((int)gridDim.x / 2) * NWAVES, 0, STAG_ITEMS);
            __syncthreads();
        }
        DenseFast S{(const bf16_t*)(ws + WS_HB), (const bf16_t*)(ws + WS_WQKV) + (size_t)LAYER * 3072 * 1024, DM, T / 256, 3072 / 256, (int)gridDim.x, (int)blockIdx.x};
        EpiQKV E{(bf16_t*)(ws + WS_Q), (const float*)(ws + WS_RSTD_IN), LAYER == 0 ? (const float*)(ws + WS_ROPE) : nullptr, 0.125f * LOG2E};
        run_gemm<0, false>(fresh_tid(wave_s), lds_raw, DM, S, E);
        PH_REP_BAR(rep, P + 0);
    }
    PH_SEAM(P + 0);
    if (PH_IN(P + 1)) for (int rep = 0; rep < PH_REPS(P + 1); ++rep) {
        if (LAYER == 0) { if (FASTATT == 2) attn_diff_fast2(fresh_tid(wave_s), lds_raw, A); else if (FASTATT == 1) attn_diff_fast(fresh_tid(wave_s), lds_raw, A); else { Frame F = make_frame(wave_s, lds_raw, ws); attn_diff_simple(F, A); } }
        else { Frame F = make_frame(wave_s, lds_raw, ws); attn_sb_simple(F, A); }
        PH_REP_BAR(rep, P + 1);
    }
    if (LAYER == 0 && FASTATT == 1) {
        PH_SEAM(P + 1);
        if (PH_IN(P + 2)) { Frame F = make_frame(wave_s, lds_raw, ws); diff_combine(F, A); }
    }
    PH_SEAM(P + 2);
    if (PH_IN(P + 3)) for (int rep = 0; rep < PH_REPS(P + 3); ++rep) {
        DenseFast S{(const bf16_t*)(ws + WS_AO), (const bf16_t*)(ws + WS_WO) + (size_t)LAYER * 1024 * 1024, DM, T / 256, DM / 256, (int)gridDim.x, (int)blockIdx.x};
        EpiRes E{(bf16_t*)(ws + WS_HB)};
        if (stag_on((int)gridDim.x) && (((int)blockIdx.x >> 3) & 1)) {
            Frame F = make_frame(wave_s, lds_raw, ws);
            conv_moe_range(A, ws, LAYER, (LAS float*)(F.lds + F.wave * 16384), F.lane, ((int)blockIdx.x >> 4) * 8 * NWAVES + ((int)blockIdx.x & 7) * NWAVES + F.wave, ((int)gridDim.x / 2) * NWAVES, STAG_ITEMS, 2 * STAG_ITEMS);
            __syncthreads();
        }
        run_gemm<1, false>(fresh_tid(wave_s), lds_raw, DM, S, E);
        PH_REP_BAR(rep, P + 3);
    }
    PH_SEAM(P + 3);
    if (PH_IN(P + 4)) { Frame F = make_frame(wave_s, lds_raw, ws); router_phase(F, A, LAYER); }
    PH_SEAM(P + 4);
    if (PH_IN(P + 5)) for (int rep = 0; rep < PH_REPS(P + 5); ++rep) {
        Frame F = make_frame(wave_s, lds_raw, ws);
        const LAS int* tl = moe_table(F.tid, F.lds, (const unsigned*)(ws + WS_CTL) + CW_CNT + LAYER * 32);
        MoeFast S{(const bf16_t*)(ws + WS_HB), (const bf16_t*)(ws + WS_WGU), (size_t)1024 * 1024, DM, 4, F.G, F.vcu, tl, (const int*)(ws + WS_ROWTOK), nullptr, -1, 0, 0, true};
        EpiGateUp E{(bf16_t*)(ws + WS_HID), (const float*)(ws + WS_ROWRS), tl, (unsigned*)(ws + WS_CTL) + CW_TILE + LAYER * 288};
        run_gemm<2, true>(F.tid, lds_raw, DM, S, E);
        if (FUSE_MOE && F.tid == 0) (void)__hip_atomic_fetch_add((unsigned*)(ws + WS_CTL) + CW_GUDONE + LAYER, 1u, __ATOMIC_RELAXED, __HIP_MEMORY_SCOPE_AGENT);
        PH_REP_BAR(rep, P + 5);
    }
    if (!FUSE_MOE) PH_SEAM(P + 5);
    if (PH_IN(P + 6)) for (int rep = 0; rep < PH_REPS(P + 6); ++rep) {
        Frame F = make_frame(wave_s, lds_raw, ws);
        const LAS int* tl = (FUSE_MOE && PH_IN(P + 5)) ? (const LAS int*)(F.lds + LDS_TL)
                                                        : moe_table(F.tid, F.lds, (const unsigned*)(ws + WS_CTL) + CW_CNT + LAYER * 32);
        int nu = 0, dh = 0, nhi = 0;
        if (FUSE_MOE) {
            int ntile = (int)(wave_sum((float)((F.lane < NE) ? tl[F.lane & 31] : 0)) + 0.5f); ntile = __builtin_amdgcn_readfirstlane(ntile);
            nu = 4 * ntile; nhi = nu % F.G; const int base = nu / F.G;
            dh = nhi == 0 ? base : (4 * nu - 7 * (F.G - nhi) + 2 * F.G) / (4 * F.G); dh = dh < 0 ? 0 : (dh > base + 1 ? base + 1 : dh); }
        MoeFast S{(const bf16_t*)(ws + WS_HID), (const bf16_t*)(ws + WS_WD), (size_t)1024 * 512, FF, 4, F.G, F.vcu, tl, (const int*)(ws + WS_ROWTOK), FUSE_MOE ? (unsigned*)(ws + WS_CTL) + CW_TILE + LAYER * 288 : nullptr, FUSE_MOE ? nu : -1, dh, nhi, false};
        if (FUSE_MOE) S.doneall = (unsigned*)(ws + WS_CTL) + CW_GUDONE + LAYER;
        EpiDown E{(bf16_t*)(ws + WS_Y), (const float*)(ws + WS_ROWGATE), tl};
        run_gemm<3, false>(F.tid, lds_raw, FF, S, E);
        PH_REP_BAR(rep, P + 6);
    }
    PH_SEAM(P + 6);
    if (PH_IN(P + 7)) {
        Frame F = make_frame(wave_s, lds_raw, ws);
        if (LAYER == 0) { row_pass<1>(F, A, nullptr, nullptr); conv_moe_layer(F, A, 1); }
        else row_pass<2>(F, A, nullptr, A.out);
    }
    PH_SEAM(P + 7);
}
__global__ void __launch_bounds__(NTHREADS, 2) hybrid_fwd(Args A) {
    extern __shared__ __attribute__((aligned(16))) unsigned char lds_raw[];
    __builtin_amdgcn_s_setreg((1 << 11) | (4 << 6) | 1, 0);
    const int wave_s = __builtin_amdgcn_readfirstlane((int)threadIdx.x >> 6);
    {
        const int t0 = fresh_tid(wave_s);
        if (t0 < 2) ((volatile LAS unsigned*)((LAS unsigned char*)lds_raw + LDS_XB))[t0] = 0u;
        if (t0 == 0) (void)xb_add((unsigned*)(A.ws + WS_CTL) + CW_BAR + XB_XCNT(xb_xcc_id()), 1u);
        __syncthreads();
    }
    if (PH_IN(0)) for (int rep = 0; rep < PH_REPS(0); ++rep) { Frame F = make_frame(wave_s, lds_raw, A.ws); p0_prologue(F, A); if (rep + 1 < PH_REPS(0)) cooperative_groups::this_grid().sync(); }
    PH_SEAM(0);
    if (A.ph_lo < 0) cooperative_groups::this_grid().sync();
    layer_phases<0>(wave_s, lds_raw, A);
    layer_phases<1>(wave_s, lds_raw, A);
}

extern "C" void kernel_launch(void* const* d_in, const int* in_sizes, int n_in, void* d_out, int out_size, void* d_ws, size_t ws_size, hipStream_t stream) {
    static int grid = 0;
    if (grid == 0) {
        if (n_in != 21 || in_sizes[0] != T * DM || out_size != T * DM || ws_size < WS_END) { fprintf(stderr, "kernel_launch: unexpected shapes / workspace (%d inputs, ws %zu)\n", n_in, ws_size); grid = -1; return; }
        int dev = 0, cus = 0;
        if (hipGetDevice(&dev) != hipSuccess || hipDeviceGetAttribute(&cus, hipDeviceAttributeMultiprocessorCount, dev) != hipSuccess) { grid = -1; return; }
        if (hipFuncSetAttribute((const void*)hybrid_fwd, hipFuncAttributeMaxDynamicSharedMemorySize, LDS_BYTES) != hipSuccess) { grid = -1; return; }
        int per_cu = 0;
        if (hipOccupancyMaxActiveBlocksPerMultiprocessor(&per_cu, (const void*)hybrid_fwd, NTHREADS, LDS_BYTES) != hipSuccess || per_cu < 1) { fprintf(stderr, "kernel_launch: occupancy query says %d blocks per CU\n", per_cu); grid = -1; return; }
        grid = cus;
    }
    if (grid < 0) return;
    (void)hipMemsetAsync((char*)d_ws + WS_CTL, 0, CTL_ZERO_BYTES, stream);
    Args a{};
    a.x = (const float*)d_in[0]; a.pos = (const int*)d_in[1]; a.norm_mix = (const float*)d_in[2]; a.norm_ffn = (const float*)d_in[3]; a.norm_final = (const float*)d_in[4];
    a.a_wqkv = (const float*)d_in[5]; a.a_lq1 = (const float*)d_in[6]; a.a_lk1 = (const float*)d_in[7]; a.a_lq2 = (const float*)d_in[8]; a.a_lk2 = (const float*)d_in[9];
    a.a_subln = (const float*)d_in[10]; a.a_wo = (const float*)d_in[11]; a.b_wqkv = (const float*)d_in[12]; a.b_wo = (const float*)d_in[13];
    a.w_group = (const float*)d_in[14]; a.b_group = (const float*)d_in[15]; a.w_expert = (const float*)d_in[16]; a.b_expert = (const float*)d_in[17];
    a.w_gate = (const float*)d_in[18]; a.w_up = (const float*)d_in[19]; a.w_down = (const float*)d_in[20];
    a.out = (float*)d_out; a.ws = (unsigned char*)d_ws;
#if MK_LAUNCHES == 1
    a.ph_lo = 0; a.ph_hi = NPHASE;
    void* kargs[] = {&a};
    hipError_t e = hipLaunchCooperativeKernel((const void*)hybrid_fwd, dim3(grid), dim3(NTHREADS), kargs, LDS_BYTES, stream);
    if (e != hipSuccess) fprintf(stderr, "kernel_launch: cooperative launch failed: %s (grid %d)\n", hipGetErrorString(e), grid);
#else
    for (int ph = 0; ph < NPHASE; ++ph) {
        a.ph_lo = ph; a.ph_hi = ph + 1;
        hipLaunchKernelGGL(hybrid_fwd, dim3(grid), dim3(NTHREADS), LDS_BYTES, stream, a);
    }
#endif
}
```
